# Optimizing an MI355X kernel written in HIP

```python
import jax
import jax.numpy as jnp
from jax import lax
import numpy as np

D_MODEL = 1024
BATCH = 8
SEQ = 4096
DEPTH = 4

GRID_W = 64
CTX_LEN = 256
HEAD_DIM = 64
D_MIX = D_MODEL
D_MLSTM = D_MIX // 2
D_NA = D_MIX - D_MLSTM
H_MLSTM = D_MLSTM // HEAD_DIM
H_NA = D_NA // HEAD_DIM
N_GATE = 4 * H_MLSTM
D_IN = 4 * D_MLSTM + 3 * D_NA + N_GATE
MLSTM_CHUNK = 64
NA_ROWS_MAX = 8
NA_COLS = 16
D_FF = 4 * D_MODEL
N_MOD = 6
ROPE_BASE = 10000.0
EPS = 1e-6
F_BIAS_LO = 3.0
F_BIAS_HI = 6.0

kernel_name = "hybrid_mlstm_natten_dit_block"


def rmsnorm(x, g):
    x32 = x.astype(jnp.float32)
    y = x32 * lax.rsqrt(jnp.mean(x32 * x32, axis=-1, keepdims=True) + EPS)
    return (y * g.astype(jnp.float32)).astype(x.dtype)


def sq_relu_mlp(h, w1, w2):
    return jnp.square(jax.nn.relu(h @ w1)) @ w2


def split_heads(a, n_heads):
    b, t, _ = a.shape
    return a.reshape(b, t, n_heads, HEAD_DIM).transpose(0, 2, 1, 3)


def merge_heads(a):
    b, h, t, d = a.shape
    return a.transpose(0, 2, 1, 3).reshape(b, t, h * d)


def head_layernorm(h, g):
    mu = jnp.mean(h, axis=-1, keepdims=True)
    var = jnp.mean(jnp.square(h - mu), axis=-1, keepdims=True)
    return merge_heads((h - mu) * lax.rsqrt(var + EPS)) * g.astype(jnp.float32)


def axial_rope_tables(n_tokens):
    t = jnp.arange(n_tokens)
    row = (t // GRID_W).astype(jnp.float32)
    col = (t % GRID_W).astype(jnp.float32)
    n_freq = HEAD_DIM // 4
    inv_freq = ROPE_BASE ** (-jnp.arange(n_freq, dtype=jnp.float32) / n_freq)
    ang = jnp.concatenate([row[:, None] * inv_freq, col[:, None] * inv_freq], axis=-1)
    return jnp.cos(ang), jnp.sin(ang)


def apply_rope(x, cos, sin):
    x1, x2 = jnp.split(x, 2, axis=-1)
    return jnp.concatenate([x1 * cos - x2 * sin, x1 * sin + x2 * cos], axis=-1)


def mlstm_scan(q, k, v, log_i, log_f, state):
    B, H, T, d = q.shape
    L = MLSTM_CHUNK
    nc = T // L

    def chunks(a):
        return jnp.moveaxis(a.reshape(a.shape[:2] + (nc, L) + a.shape[3:]), 2, 0)

    causal = jnp.tril(jnp.ones((L, L), dtype=bool))

    def step(carry, xs):
        C, n, m = carry
        qc, kc, vc, ic, fc = xs
        b = jnp.cumsum(fc, axis=-1)
        d_intra = jnp.where(causal, b[..., :, None] - b[..., None, :] + ic[..., None, :], -jnp.inf)
        d_prev = b + m[..., None]
        m_t = jnp.maximum(d_prev, jnp.max(d_intra, axis=-1))
        w_intra = jnp.exp(d_intra - m_t[..., None])
        w_prev = jnp.exp(d_prev - m_t)
        s = jnp.einsum('bhtd,bhsd->bhts', qc, kc) * w_intra
        num = w_prev[..., None] * jnp.einsum('bhtd,bhde->bhte', qc, C) + jnp.einsum('bhts,bhse->bhte', s, vc)
        qn = w_prev * jnp.einsum('bhtd,bhd->bht', qc, n) + jnp.sum(s, axis=-1)
        h = num / jnp.maximum(jnp.abs(qn), jnp.exp(-m_t))[..., None]
        b_end = b[..., -1]
        d_end = b_end[..., None] - b + ic
        m_new = jnp.maximum(b_end + m, jnp.max(d_end, axis=-1))
        w_c = jnp.exp(b_end + m - m_new)
        w_s = jnp.exp(d_end - m_new[..., None])
        C = w_c[..., None, None] * C + jnp.einsum('bhs,bhsd,bhse->bhde', w_s, kc, vc)
        n = w_c[..., None] * n + jnp.einsum('bhs,bhsd->bhd', w_s, kc)
        return (C, n, m_new), h

    state, h = lax.scan(step, state, (chunks(q), chunks(k), chunks(v), chunks(log_i), chunks(log_f)))
    return jnp.moveaxis(h, 0, 2).reshape(B, H, T, d), state


def mlstm_group(q, k, v, o, gates, qc, kc, vc, oc, gates_c, b_gate, norm_g, cos, sin, need_ctx):
    f32 = jnp.float32
    scale = HEAD_DIM ** -0.5

    def prep(a):
        return split_heads(a, H_MLSTM).astype(f32)

    qx = apply_rope(prep(q), cos, sin) * scale
    kx = apply_rope(prep(k), cos, sin)
    vx = prep(v)
    qcx = prep(qc) * scale
    kcx = prep(kc)
    vcx = prep(vc)

    def gate_split(g):
        return jnp.split((g.astype(f32) + b_gate.astype(f32)).transpose(0, 2, 1), 4, axis=1)

    i_fw, i_bw, f_fw, f_bw = gate_split(gates)
    ic_fw, ic_bw, fc_fw, fc_bw = gate_split(gates_c)
    B, H, _, d = qx.shape
    state0 = (jnp.zeros((B, H, d, d), f32), jnp.zeros((B, H, d), f32), jnp.zeros((B, H), f32))

    def direction(rev, ig, fg, igc, fgc):
        flip = (lambda a: jnp.flip(a, axis=2)) if rev else (lambda a: a)
        hc, st = mlstm_scan(flip(qcx), flip(kcx), flip(vcx), flip(igc), jax.nn.log_sigmoid(flip(fgc)), state0)
        hx, _ = mlstm_scan(flip(qx), flip(kx), flip(vx), flip(ig), jax.nn.log_sigmoid(flip(fg)), st)
        return flip(hx), flip(hc)

    hx_f, hc_f = direction(False, i_fw, f_fw, ic_fw, fc_fw)
    hx_b, hc_b = direction(True, i_bw, f_bw, ic_bw, fc_bw)
    y = (head_layernorm(hx_f + hx_b, norm_g) * jax.nn.sigmoid(o.astype(f32))).astype(q.dtype)
    yc = None
    if need_ctx:
        yc = (head_layernorm(hc_f + hc_b, norm_g) * jax.nn.sigmoid(oc.astype(f32))).astype(q.dtype)
    return y, yc


def neighborhood_attention(q, k, v, qc, kc, vc, rpb, rows, need_ctx):
    B, S, _ = q.shape
    scale = HEAD_DIM ** -0.5
    kr_n = min(NA_ROWS_MAX, rows)

    def grid(a):
        return split_heads(a, H_NA).reshape(B, H_NA, rows, GRID_W, HEAD_DIM)

    qg = grid(q * scale)
    kg = grid(k)
    vg = grid(v)
    kch = split_heads(kc, H_NA)
    vch = split_heads(vc, H_NA)
    cols = jnp.arange(GRID_W)
    col_start = jnp.clip(cols - NA_COLS // 2, 0, GRID_W - NA_COLS)
    col_mask = (cols[None, :] >= col_start[:, None]) & (cols[None, :] < col_start[:, None] + NA_COLS)
    dc_idx = jnp.clip(cols[None, :] - cols[:, None] + NA_COLS - 1, 0, 2 * NA_COLS - 2)
    rpb_cols = rpb.astype(jnp.float32)[:, :, dc_idx]

    def row_block(r):
        rs = jnp.clip(r - kr_n // 2, 0, rows - kr_n)
        q_r = lax.dynamic_index_in_dim(qg, r, axis=2, keepdims=False)
        k_r = lax.dynamic_slice_in_dim(kg, rs, kr_n, axis=2)
        v_r = lax.dynamic_slice_in_dim(vg, rs, kr_n, axis=2)
        bias = jnp.take(rpb_cols, rs + jnp.arange(kr_n) - r + NA_ROWS_MAX - 1, axis=1)
        s_loc = jnp.einsum('bhqd,bhrkd->bhqrk', q_r, k_r).astype(jnp.float32) + bias.transpose(0, 2, 1, 3)
        s_loc = jnp.where(col_mask[:, None, :], s_loc, -jnp.inf)
        s_ctx = jnp.einsum('bhqd,bhcd->bhqc', q_r, kch).astype(jnp.float32)
        s = jnp.concatenate([s_loc.reshape(B, H_NA, GRID_W, kr_n * GRID_W), s_ctx], axis=-1)
        p = jax.nn.softmax(s, axis=-1).astype(v.dtype)
        p_loc = p[..., :kr_n * GRID_W].reshape(B, H_NA, GRID_W, kr_n, GRID_W)
        p_ctx = p[..., kr_n * GRID_W:]
        return jnp.einsum('bhqrk,bhrkd->bhqd', p_loc, v_r) + jnp.einsum('bhqc,bhcd->bhqd', p_ctx, vch)

    out = lax.map(row_block, jnp.arange(rows))
    y = out.transpose(1, 0, 3, 2, 4).reshape(B, S, H_NA * HEAD_DIM)
    yc = None
    if need_ctx:
        qch = split_heads(qc * scale, H_NA)
        sc = jnp.einsum('bhqd,bhkd->bhqk', qch, kch).astype(jnp.float32)
        pc = jax.nn.softmax(sc, axis=-1).astype(vc.dtype)
        yc = merge_heads(jnp.einsum('bhqk,bhkd->bhqd', pc, vch))
    return y, yc


def token_mixers(p, pc, b_gate, norm_g, rpb, cos, sin, rows, need_ctx):
    cuts = [int(i) for i in np.cumsum([D_MLSTM] * 4 + [D_NA] * 3)]
    qm, km, vm, om, qn, kn, vn, gm = jnp.split(p, cuts, axis=-1)
    qmc, kmc, vmc, omc, qnc, knc, vnc, gmc = jnp.split(pc, cuts, axis=-1)
    y_m, yc_m = mlstm_group(qm, km, vm, om, gm, qmc, kmc, vmc, omc, gmc, b_gate, norm_g, cos, sin, need_ctx)
    y_n, yc_n = neighborhood_attention(qn, kn, vn, qnc, knc, vnc, rpb, rows, need_ctx)
    y = jnp.concatenate([y_m, y_n], axis=-1)
    yc = jnp.concatenate([yc_m, yc_n], axis=-1) if need_ctx else None
    return y, yc


def setup_inputs(seed: int = 0) -> dict:
    key = jax.random.key(seed)
    ks = jax.random.split(key, 16)
    nrm = jax.random.normal
    f32 = jnp.float32
    x = nrm(ks[0], (BATCH, SEQ, D_MODEL), f32)
    c = nrm(ks[1], (BATCH, D_MODEL), f32)
    ctx = nrm(ks[2], (BATCH, CTX_LEN, D_MODEL), f32)
    c_ctx = nrm(ks[3], (D_MODEL,), f32)
    w_ada = nrm(ks[4], (DEPTH, D_MODEL, N_MOD * D_MODEL), f32) * (0.5 * D_MODEL ** -0.5)
    b_ada = 0.02 * nrm(ks[5], (DEPTH, N_MOD * D_MODEL), f32)
    norm1_g = 1.0 + 0.02 * nrm(ks[6], (DEPTH, D_MODEL), f32)
    w_in = nrm(ks[7], (DEPTH, D_MODEL, D_IN), f32) * D_MODEL ** -0.5
    i_bias = 0.1 * nrm(ks[8], (DEPTH, 2 * H_MLSTM), f32)
    f_base = jnp.tile(jnp.linspace(F_BIAS_LO, F_BIAS_HI, H_MLSTM, dtype=f32), 2)
    f_bias = f_base[None, :] + 0.1 * nrm(ks[9], (DEPTH, 2 * H_MLSTM), f32)
    b_gate = jnp.concatenate([i_bias, f_bias], axis=-1)
    mlstm_norm_g = 1.0 + 0.02 * nrm(ks[10], (DEPTH, D_MLSTM), f32)
    rpb = 0.1 * nrm(ks[11], (DEPTH, H_NA, 2 * NA_ROWS_MAX - 1, 2 * NA_COLS - 1), f32)
    w_out = nrm(ks[12], (DEPTH, D_MIX, D_MODEL), f32) * D_MIX ** -0.5
    norm2_g = 1.0 + 0.02 * nrm(ks[13], (DEPTH, D_MODEL), f32)
    km1, km2 = jax.random.split(ks[14])
    w_mlp1 = nrm(km1, (DEPTH, D_MODEL, D_FF), f32) * D_MODEL ** -0.5
    w_mlp2 = nrm(km2, (DEPTH, D_FF, D_MODEL), f32) * D_FF ** -0.5
    final_g = 1.0 + 0.02 * nrm(ks[15], (D_MODEL,), f32)
    return {"x": x, "c": c, "ctx": ctx, "c_ctx": c_ctx, "w_ada": w_ada, "b_ada": b_ada,
            "norm1_g": norm1_g, "w_in": w_in, "b_gate": b_gate, "mlstm_norm_g": mlstm_norm_g,
            "rpb": rpb, "w_out": w_out, "norm2_g": norm2_g, "w_mlp1": w_mlp1, "w_mlp2": w_mlp2,
            "final_g": final_g}


def reference(x, c, ctx, c_ctx, w_ada, b_ada, norm1_g, w_in, b_gate, mlstm_norm_g, rpb, w_out,
              norm2_g, w_mlp1, w_mlp2, final_g):
    B, S, D = x.shape
    rows = S // GRID_W
    cos, sin = axial_rope_tables(S)
    silu_c = jax.nn.silu(c)
    silu_cc = jax.nn.silu(c_ctx)
    xc = ctx
    for l in range(DEPTH):
        need_ctx = l < DEPTH - 1
        mod = silu_c @ w_ada[l] + b_ada[l]
        mod_c = silu_cc @ w_ada[l] + b_ada[l]
        sh1, sc1, g1, sh2, sc2, g2 = jnp.split(mod[:, None, :], N_MOD, axis=-1)
        sh1c, sc1c, g1c, sh2c, sc2c, g2c = jnp.split(mod_c, N_MOD, axis=-1)
        h = rmsnorm(x, norm1_g[l]) * (1.0 + sc1) + sh1
        hc = rmsnorm(xc, norm1_g[l]) * (1.0 + sc1c) + sh1c
        y, yc = token_mixers(h @ w_in[l], hc @ w_in[l], b_gate[l], mlstm_norm_g[l], rpb[l],
                             cos, sin, rows, need_ctx)
        x = x + g1 * (y @ w_out[l])
        h = rmsnorm(x, norm2_g[l]) * (1.0 + sc2) + sh2
        x = x + g2 * sq_relu_mlp(h, w_mlp1[l], w_mlp2[l])
        if need_ctx:
            xc = xc + g1c * (yc @ w_out[l])
            hc = rmsnorm(xc, norm2_g[l]) * (1.0 + sc2c) + sh2c
            xc = xc + g2c * sq_relu_mlp(hc, w_mlp1[l], w_mlp2[l])
    return rmsnorm(x, final_g)
```

```cpp
#include <hip/hip_runtime.h>
#include <hip/hip_cooperative_groups.h>
#include <cstdio>
#include <cstdint>
namespace cg = cooperative_groups;

typedef unsigned short bf16_t;
typedef short bf16x8 __attribute__((ext_vector_type(8)));
typedef float f32x4 __attribute__((ext_vector_type(4)));
typedef unsigned u32x4 __attribute__((ext_vector_type(4)));
typedef unsigned u32x2 __attribute__((ext_vector_type(2)));

constexpr int D = 1024, NB = 8, SEQ = 4096, DEPTH = 4, CTXL = 256;
constexpr int DIN = 3616, DINP = 3840, PW = 3584, DFF = 4096;
constexpr int NLAT = NB * SEQ, NCTX = NB * CTXL, MTOT = NLAT + NCTX;
constexpr int NMODC = 6 * D;
constexpr int LDSS = 72;
constexpr int NTHR = 512, NWAVE = 8;
constexpr int SHM_BYTES = 131072;

constexpr size_t WS_CTL = 0;
constexpr size_t WS_MODS = 16384;
constexpr size_t WS_ROPE = WS_MODS + (size_t)DEPTH * 9 * NMODC * 4;
constexpr size_t WS_GATES = WS_ROPE + (size_t)2 * SEQ * 32 * 4;
constexpr size_t WS_XC = WS_GATES + (size_t)MTOT * 32 * 4;
constexpr size_t WS_WIN = WS_XC + (size_t)NCTX * D * 4;
constexpr size_t WS_WOUT = WS_WIN + (size_t)DINP * D * 2;
constexpr size_t WS_W1 = WS_WOUT + (size_t)D * D * 2;
constexpr size_t WS_W2 = WS_W1 + (size_t)DFF * D * 2;
constexpr size_t WS_HB = WS_W2 + (size_t)DFF * D * 2;
constexpr size_t WS_HFB = WS_HB + (size_t)MTOT * D * 2;
constexpr size_t WS_PA = WS_HFB + (size_t)2 * MTOT * 512 * 2;
constexpr size_t WS_END = WS_PA + (size_t)MTOT * DFF * 2;
static_assert(WS_ROPE % 256 == 0 && WS_GATES % 256 == 0 && WS_XC % 256 == 0 && WS_WIN % 256 == 0 && WS_HB % 256 == 0 && WS_HFB % 256 == 0 && WS_PA % 256 == 0, "align");

constexpr int TPB = SEQ + CTXL;
constexpr size_t HM_T = (size_t)NB * 8 * TPB * 64;
constexpr size_t OG_OFF = 6 * HM_T;
static_assert(OG_OFF + (size_t)MTOT * 512 == (size_t)MTOT * PW, "layout");
__device__ __forceinline__ size_t hm_off(int ten, int b, int h, int tt) { return (size_t)ten * HM_T + ((size_t)(b * 8 + h) * TPB + tt) * 64; }

struct Params {
    const float *x, *c, *ctx, *c_ctx, *w_ada, *b_ada, *norm1_g, *w_in, *b_gate, *mlstm_norm_g, *rpb, *w_out, *norm2_g, *w_mlp1, *w_mlp2, *final_g;
    float* out;
    unsigned char* ws;
    int ph_lo, ph_hi;
};

__device__ __forceinline__ unsigned pk2(float lo, float hi) { unsigned r; asm("v_cvt_pk_bf16_f32 %0, %1, %2" : "=v"(r) : "v"(lo), "v"(hi)); return r; }
__device__ __forceinline__ bf16_t f2bf(float f) { return (bf16_t)(pk2(f, 0.f) & 0xffffu); }
__device__ __forceinline__ float bf2f(unsigned v) { return __uint_as_float(v << 16); }
__device__ __forceinline__ float bflo(unsigned w) { return __uint_as_float(w << 16); }
__device__ __forceinline__ float bfhi(unsigned w) { return __uint_as_float(w & 0xffff0000u); }
__device__ __forceinline__ float wave_sum(float v) {
#pragma unroll
    for (int o = 1; o < 64; o <<= 1) v += __shfl_xor(v, o);
    return v;
}
__device__ __forceinline__ int otid() { int t = threadIdx.x; asm volatile("" : "+v"(t)); return t; }
__device__ __forceinline__ f32x4 mfma16(bf16x8 a, bf16x8 b, f32x4 c) { return __builtin_amdgcn_mfma_f32_16x16x32_bf16(a, b, c, 0, 0, 0); }
__device__ __forceinline__ bf16x8 as_bf16x8(u32x4 v) { return __builtin_bit_cast(bf16x8, v); }

__device__ void phase_prologue(const Params& p, unsigned char* smem) {
    float* sl = (float*)smem;
    float* red = sl + 9 * 1024;
    const int tid = otid();
    {
        float* cosT = (float*)(p.ws + WS_ROPE);
        float* sinT = cosT + SEQ * 32;
        for (int i = blockIdx.x * NTHR + tid; i < SEQ * 32; i += gridDim.x * NTHR) {
            const int t = i >> 5, dp = i & 31;
            const float pos = (dp < 16) ? (float)(t >> 6) : (float)(t & 63);
            const float inv = exp2f(-(float)(dp & 15) * (13.287712379549449f / 16.f));
            const float ang = pos * inv;
            cosT[i] = __cosf(ang);
            sinT[i] = __sinf(ang);
        }
    }
    {
        const f32x4* src = (const f32x4*)p.ctx; f32x4* dst = (f32x4*)(p.ws + WS_XC);
        for (int i = blockIdx.x * NTHR + tid; i < NCTX * D / 4; i += gridDim.x * NTHR) dst[i] = src[i];
    }
    if (blockIdx.x >= DEPTH * 96) return;
    for (int i = tid; i < 9 * 1024; i += NTHR) {
        const int r = i >> 10, k = i & 1023;
        const float v = (r < 8) ? p.c[r * 1024 + k] : p.c_ctx[k];
        sl[i] = v / (1.f + __expf(-v));
    }
    __syncthreads();
    float* mods = (float*)(p.ws + WS_MODS);
    for (int item = blockIdx.x; item < DEPTH * 96; item += gridDim.x) {
        const int l = item / 96, cb = item % 96, cl = tid & 63, kg = tid >> 6;
        const float* w = p.w_ada + (size_t)l * D * NMODC + cb * 64 + cl;
        float acc[9];
#pragma unroll
        for (int r = 0; r < 9; ++r) acc[r] = 0.f;
#pragma unroll 32
        for (int k = kg * 128; k < kg * 128 + 128; ++k) {
            const float wv = w[(size_t)k * NMODC];
#pragma unroll
            for (int r = 0; r < 9; ++r) acc[r] += sl[r * 1024 + k] * wv;
        }
#pragma unroll
        for (int r = 0; r < 9; ++r) red[(kg * 9 + r) * 64 + cl] = acc[r];
        __syncthreads();
        for (int i = tid; i < 9 * 64; i += NTHR) {
            const int r = i >> 6, c2 = i & 63;
            float s = 0.f;
#pragma unroll
            for (int g8 = 0; g8 < 8; ++g8) s += red[(g8 * 9 + r) * 64 + c2];
            mods[(size_t)(l * 9 + r) * NMODC + cb * 64 + c2] = s + p.b_ada[l * NMODC + cb * 64 + c2];
        }
        __syncthreads();
    }
}

__device__ __forceinline__ void norm_store_row(const f32x4 (&v)[4], int row, int b, int lane, const float* g, const float* modl, int sh_off, int sc_off, bf16_t* outp) {
    float s = 0.f;
#pragma unroll
    for (int j = 0; j < 4; ++j) s += (v[j].x * v[j].x + v[j].y * v[j].y) + (v[j].z * v[j].z + v[j].w * v[j].w);
    s = wave_sum(s);
    const float rstd = 1.0f / sqrtf(s * (1.f / D) + 1e-6f);
    const float* sh = modl + b * NMODC + sh_off;
    const float* sc = modl + b * NMODC + sc_off;
#pragma unroll
    for (int j = 0; j < 4; ++j) {
        const int col = (lane + 64 * j) * 4;
        const f32x4 gv = *(const f32x4*)(g + col), scv = *(const f32x4*)(sc + col), shv = *(const f32x4*)(sh + col);
        const f32x4 o = (v[j] * rstd * gv) * (1.f + scv) + shv;
        u32x2 wv; wv.x = pk2(o.x, o.y); wv.y = pk2(o.z, o.w);
        *(u32x2*)(outp + (size_t)row * D + col) = wv;
    }
}
__device__ void norm_rows(const float* xlat, float* xctx, int nrows, const float* g, const float* modl, int sh_off, int sc_off, bf16_t* outp, const float* part, int npart) {
    const int tid = otid(), lane = tid & 63;
    const int nw = gridDim.x * NWAVE, w0 = blockIdx.x * NWAVE + (tid >> 6);
    for (int row = w0; row < NLAT; row += 4 * nw) {
        f32x4 v[4][4];
#pragma unroll
        for (int i = 0; i < 4; ++i) {
            const int r = min(row + i * nw, NLAT - 1);
#pragma unroll
            for (int j = 0; j < 4; ++j) v[i][j] = ((const f32x4*)(xlat + (size_t)r * D))[lane + 64 * j];
        }
#pragma unroll
        for (int i = 0; i < 4; ++i) {
            const int r = row + i * nw;
            if (r < NLAT) norm_store_row(v[i], r, r >> 12, lane, g, modl, sh_off, sc_off, outp);
        }
    }
    for (int row = NLAT + w0; row < nrows; row += nw) {
        const float* xr = xctx + (size_t)(row - NLAT) * D;
        f32x4 v[4];
#pragma unroll
        for (int j = 0; j < 4; ++j) v[j] = ((const f32x4*)xr)[lane + 64 * j];
        if (npart > 0) {
            for (int sl = 0; sl < npart; ++sl) {
                const f32x4* pr = (const f32x4*)(part + (size_t)sl * NCTX * D + (size_t)(row - NLAT) * D);
#pragma unroll
                for (int j = 0; j < 4; ++j) v[j] += pr[lane + 64 * j];
            }
#pragma unroll
            for (int j = 0; j < 4; ++j) ((f32x4*)(xctx + (size_t)(row - NLAT) * D))[lane + 64 * j] = v[j];
        }
        norm_store_row(v, row, 8, lane, g, modl, sh_off, sc_off, outp);
    }
}

__device__ __forceinline__ int rope_perm(int n) { return ((n >> 5) & 1) * 16 + (n & 15) + 32 * ((n >> 4) & 1); }
__device__ __forceinline__ void transpose_item(const float* W, int K, int N, bf16_t* WT, int kt, int nt, float* tile, int nperm) {
    const int tid = otid(), k0 = kt * 64, n0 = nt * 64;
    {
        const int r = tid >> 4, c4 = (tid & 15) * 4;
#pragma unroll
        for (int ps = 0; ps < 2; ++ps) {
            const int k = ps * 32 + r;
            f32x4 v = {0.f, 0.f, 0.f, 0.f};
            if (n0 + c4 < N) v = *(const f32x4*)(W + (size_t)(k0 + k) * N + n0 + c4);
            tile[k * 65 + c4 + 0] = v.x; tile[k * 65 + c4 + 1] = v.y; tile[k * 65 + c4 + 2] = v.z; tile[k * 65 + c4 + 3] = v.w;
        }
    }
    __syncthreads();
    {
        const int kg = tid & 7, n = tid >> 3;
        const int nl = (n0 < nperm) ? rope_perm(n) : n;
        const float* s = tile + (kg * 8) * 65 + nl;
        u32x4 o; o.x = pk2(s[0], s[65]); o.y = pk2(s[2 * 65], s[3 * 65]); o.z = pk2(s[4 * 65], s[5 * 65]); o.w = pk2(s[6 * 65], s[7 * 65]);
        *(u32x4*)(WT + (size_t)(n0 + n) * K + k0 + kg * 8) = o;
    }
    __syncthreads();
}
__device__ void convert_weights(const Params& p, int l, unsigned char* smem) {
    float* tile = (float*)smem;
    constexpr int I_IN = 16 * (DINP / 64), I_OUT = 16 * 16, I_1 = 16 * 64, I_2 = 64 * 16;
    for (int it = blockIdx.x; it < I_IN + I_OUT + I_1 + I_2; it += gridDim.x) {
        int r = it;
        if (r < I_IN) { transpose_item(p.w_in + (size_t)l * D * DIN, D, DIN, (bf16_t*)(p.ws + WS_WIN), r % 16, r / 16, tile, 1024); continue; }
        r -= I_IN;
        if (r < I_OUT) { transpose_item(p.w_out + (size_t)l * D * D, D, D, (bf16_t*)(p.ws + WS_WOUT), r % 16, r / 16, tile, 0); continue; }
        r -= I_OUT;
        if (r < I_1) { transpose_item(p.w_mlp1 + (size_t)l * D * DFF, D, DFF, (bf16_t*)(p.ws + WS_W1), r % 16, r / 16, tile, 0); continue; }
        r -= I_1;
        transpose_item(p.w_mlp2 + (size_t)l * DFF * D, DFF, D, (bf16_t*)(p.ws + WS_W2), r % 64, r / 64, tile, 0);
    }
}

constexpr int G_BM = 256, G_BK = 64, G_HALF = 128, G_HT = G_HALF * G_BK;
__device__ __forceinline__ int lds_byte(int r, int c) { const int st = (r >> 4) * 2 + (c >> 5), rr = r & 15, cc = c & 31, ob = rr * 64 + cc * 2; return st * 1024 + (ob ^ (((ob >> 9) & 1) << 5)); }
__device__ __forceinline__ void stage_rc(int b, int& R, int& C) { const int st = b / 1024, sb = b % 1024, swz = sb ^ (((sb >> 9) & 1) << 5); R = (st >> 1) * 16 + swz / 64; C = (st & 1) * 32 + (swz % 64) / 2; }
#define LAS __attribute__((address_space(3)))
template <class Epi>
__device__ __forceinline__ void gemm_phase(const bf16_t* __restrict__ A, const bf16_t* __restrict__ Bt, int M, int N, int K, const Epi& epi, unsigned char* smem, int S = 1) {
    LAS unsigned char* lds = (LAS unsigned char*)smem;
    const int tid = otid(), wid = __builtin_amdgcn_readfirstlane(tid >> 6), lane = tid & 63, wr = wid >> 2, wc = wid & 3, fr = lane & 15, fq = lane >> 4;
    unsigned voff[2];
#pragma unroll
    for (int i = 0; i < 2; ++i) { int R, C; stage_rc(tid * 16 + i * 8192, R, C); voff[i] = (unsigned)(R * K + C) * 2u; }
    const size_t hstep = (size_t)G_HALF * K * 2;
    const unsigned ldsw = (unsigned)wid * 1024u;
    const int aoff = lds_byte(wr * 64 + fr, fq * 8), boff = lds_byte(wc * 32 + fr, fq * 8);
#define SA(b, h) (((b) * 2 + (h)) * 16384)
#define SB(b, h) ((4 + (b) * 2 + (h)) * 16384)
#define STAGE(bufoff, gbase) do { _Pragma("unroll") for (int _i = 0; _i < 2; ++_i) \
      __builtin_amdgcn_global_load_lds((const unsigned*)((const char*)(gbase) + voff[_i]), (LAS unsigned*)(lds + (bufoff) + ldsw + _i * 8192), 16, 0, 0); } while (0)
#define LDA(dst, b, h) do { _Pragma("unroll") for (int m = 0; m < 4; ++m) _Pragma("unroll") for (int k = 0; k < 2; ++k) dst[m][k] = *(const LAS bf16x8*)(lds + SA(b, h) + aoff + m * 2048 + k * 1024); } while (0)
#define LDB(dst, b, h) do { _Pragma("unroll") for (int n = 0; n < 2; ++n) _Pragma("unroll") for (int k = 0; k < 2; ++k) dst[n][k] = *(const LAS bf16x8*)(lds + SB(b, h) + boff + n * 2048 + k * 1024); } while (0)
#define MMA(ai, bj, At_, Bt_) do { __builtin_amdgcn_s_setprio(1); \
    _Pragma("unroll") for (int m = 0; m < 4; ++m) _Pragma("unroll") for (int n = 0; n < 2; ++n) _Pragma("unroll") for (int k = 0; k < 2; ++k) \
      acc[ai][bj][m][n] = __builtin_amdgcn_mfma_f32_16x16x32_bf16(Bt_[n][k], At_[m][k], acc[ai][bj][m][n], 0, 0, 0); \
    __builtin_amdgcn_s_setprio(0); } while (0)
#define WAIT_V(n) asm volatile("s_waitcnt vmcnt(" #n ")" ::: "memory")
#define WAIT_L(n) asm volatile("s_waitcnt lgkmcnt(" #n ")" ::: "memory")
#define BAR __builtin_amdgcn_s_barrier()
#define SCHED __builtin_amdgcn_sched_barrier(0)
    const int nM = M / G_BM, nN = N / G_BM, nMf = (S > 1) ? (NLAT / G_BM) : nM, nwg = nMf * nN, nsp = (nM - nMf) * nN * S, ksl = K / S;
    auto unit = [&](int round, int& brow, int& bcol, int& k0) __attribute__((always_inline)) -> bool {
        int wgid = round * (int)gridDim.x + (int)blockIdx.x;
        if (wgid >= nwg + nsp) return false;
        if (wgid >= nwg) { const int r = wgid - nwg, tl = r / S; k0 = (r - tl * S) * ksl; brow = (nMf + tl % (nM - nMf)) * G_BM; bcol = (tl / (nM - nMf)) * G_BM; return true; }
        { const int q = nwg / 8, r = nwg % 8, xcd = wgid % 8, off = wgid / 8; wgid = (xcd < r ? xcd * (q + 1) : r * (q + 1) + (xcd - r) * q) + off; }
        const int nig = 8 * nN, gid = wgid / nig, fm = gid * 8, gsz = min(nMf - fm, 8);
        brow = (fm + ((wgid % nig) % gsz)) * G_BM; bcol = ((wgid % nig) / gsz) * G_BM; k0 = 0;
        return true;
    };
    int ui = 0, brow, bcol, k0;
    if (!unit(0, brow, bcol, k0)) return;
    const char* cA = (const char*)A + ((size_t)brow * K + k0) * 2;
    const char* cB = (const char*)Bt + ((size_t)bcol * K + k0) * 2;
    f32x4 acc[2][2][4][2];
#pragma unroll
    for (int a0 = 0; a0 < 2; ++a0)
#pragma unroll
        for (int a1 = 0; a1 < 2; ++a1)
#pragma unroll
            for (int a2 = 0; a2 < 4; ++a2)
#pragma unroll
                for (int a3 = 0; a3 < 2; ++a3) acc[a0][a1][a2][a3] = (f32x4){0.f, 0.f, 0.f, 0.f};
    bf16x8 At[4][2], B0[2][2], B1[2][2];
    STAGE(SB(0, 0), cB); STAGE(SB(0, 1), cB + hstep); STAGE(SA(0, 0), cA); STAGE(SA(0, 1), cA + hstep);
    if (wr == 1) BAR;
    WAIT_V(2); BAR;
    STAGE(SB(1, 0), cB + 128); STAGE(SA(1, 0), cA + 128); STAGE(SB(1, 1), cB + hstep + 128);
    WAIT_V(6); BAR;
#pragma unroll 1
    for (;;) {
        int nbrow = 0, nbcol = 0, nk0 = 0;
        const bool has_next = unit(ui + 1, nbrow, nbcol, nk0);
        const bool split = brow >= nMf * G_BM;
        const int nt = (split ? ksl : K) / G_BK;
        const char* nA = has_next ? (const char*)A + ((size_t)nbrow * K + nk0) * 2 : cA;
        const char* nB = has_next ? (const char*)Bt + ((size_t)nbcol * K + nk0) * 2 : cB;
#pragma unroll 1
        for (int t = 0; t < nt; t += 2) {
            const bool last = (t == nt - 2);
            const char* a1 = cA + (size_t)(t + 1) * 128;
            const char* a2 = last ? nA : cA + (size_t)(t + 2) * 128; const char* b2 = last ? nB : cB + (size_t)(t + 2) * 128;
            const char* a3 = a2 + 128; const char* b3 = b2 + 128;
            LDB(B0, 0, 0); LDB(B1, 0, 1); SCHED; LDA(At, 0, 0); STAGE(SA(1, 1), a1 + hstep);
            WAIT_V(8); WAIT_L(0); BAR; MMA(0, 0, At, B0); MMA(0, 1, At, B1); BAR; SCHED;
            LDA(At, 0, 1); STAGE(SB(0, 0), b2); STAGE(SB(0, 1), b2 + hstep); STAGE(SA(0, 0), a2);
            WAIT_V(8); WAIT_L(0); BAR; MMA(1, 0, At, B0); MMA(1, 1, At, B1); BAR; SCHED;
            LDB(B0, 1, 0); LDB(B1, 1, 1); SCHED; LDA(At, 1, 0); STAGE(SA(0, 1), a2 + hstep);
            WAIT_V(8); WAIT_L(0); BAR; MMA(0, 0, At, B0); MMA(0, 1, At, B1); BAR; SCHED;
            LDA(At, 1, 1); STAGE(SB(1, 0), b3); STAGE(SB(1, 1), b3 + hstep); STAGE(SA(1, 0), a3);
            WAIT_V(8); WAIT_L(0); BAR; MMA(1, 0, At, B0); MMA(1, 1, At, B1); BAR; SCHED;
        }
        if (wr == 0) BAR;
        epi(acc, brow + wr * 64 + fr, bcol + wc * 32 + fq * 4, wc, fq, split ? k0 / ksl : -1);
        if (!has_next) break;
#pragma unroll
        for (int a0 = 0; a0 < 2; ++a0)
#pragma unroll
            for (int a1 = 0; a1 < 2; ++a1)
#pragma unroll
                for (int a2 = 0; a2 < 4; ++a2)
#pragma unroll
                    for (int a3 = 0; a3 < 2; ++a3) acc[a0][a1][a2][a3] = (f32x4){0.f, 0.f, 0.f, 0.f};
        cA = nA; cB = nB; brow = nbrow; bcol = nbcol; k0 = nk0; ++ui;
        if (wr == 1) BAR;
    }
    WAIT_V(0);
    BAR;
#undef SA
#undef SB
#undef STAGE
#undef LDA
#undef LDB
#undef MMA
#undef WAIT_V
#undef WAIT_L
#undef BAR
#undef SCHED
}

struct EpiInProj {
    bf16_t* P; float* gates; const float* cosT; const float* sinT;
    __device__ __forceinline__ void operator()(f32x4 (&acc)[2][2][4][2], int row0, int col0, int wc, int fq, int slice) const {
        if (col0 >= PW) {
            if (wc == 0) {
#pragma unroll
                for (int ai = 0; ai < 2; ++ai)
#pragma unroll
                    for (int m = 0; m < 4; ++m) {
                        const int row = row0 + ai * 128 + m * 16;
#pragma unroll
                        for (int n = 0; n < 2; ++n) *(f32x4*)(gates + (size_t)row * 32 + n * 16 + fq * 4) = acc[ai][0][m][n];
                    }
            }
            return;
        }
        const bool lat = row0 < NLAT;
        const int bb = lat ? (row0 >> 12) : ((row0 - NLAT) >> 8);
        const int tt0 = lat ? (row0 & (SEQ - 1)) : (SEQ + ((row0 - NLAT) & (CTXL - 1)));
        if (col0 < 1024) {
            const float scale = (col0 < 512) ? 0.125f : 1.f;
            const int dl = (wc & 1) * 16 + fq * 4;
#pragma unroll
            for (int bj = 0; bj < 2; ++bj) {
                const int c = (col0 + bj * 128) & ~63;
                bf16_t* base = P + hm_off(c >> 9, bb, (c & 511) >> 6, tt0) + dl;
#pragma unroll
                for (int ai = 0; ai < 2; ++ai)
#pragma unroll
                    for (int m = 0; m < 4; ++m) {
                        const int dr = ai * 128 + m * 16;
                        f32x4 x1 = acc[ai][bj][m][0], x2 = acc[ai][bj][m][1];
                        if (lat) {
                            const int t = tt0 + dr;
                            const f32x4 c4 = *(const f32x4*)(cosT + t * 32 + dl), s4 = *(const f32x4*)(sinT + t * 32 + dl);
                            const f32x4 y1 = x1 * c4 - x2 * s4, y2 = x1 * s4 + x2 * c4;
                            x1 = y1; x2 = y2;
                        }
                        x1 = x1 * scale; x2 = x2 * scale;
                        u32x2 w1; w1.x = pk2(x1.x, x1.y); w1.y = pk2(x1.z, x1.w);
                        u32x2 w2; w2.x = pk2(x2.x, x2.y); w2.y = pk2(x2.z, x2.w);
                        *(u32x2*)(base + (size_t)dr * 64) = w1;
                        *(u32x2*)(base + (size_t)dr * 64 + 32) = w2;
                    }
            }
            return;
        }
        if (col0 >= 1536 && col0 < 2048) {
#pragma unroll
            for (int ai = 0; ai < 2; ++ai)
#pragma unroll
                for (int m = 0; m < 4; ++m) {
                    const int row = row0 + ai * 128 + m * 16;
#pragma unroll
                    for (int bj = 0; bj < 2; ++bj)
#pragma unroll
                        for (int n = 0; n < 2; ++n) {
                            const f32x4 v = acc[ai][bj][m][n];
                            u32x2 wv; wv.x = pk2(v.x, v.y); wv.y = pk2(v.z, v.w);
                            *(u32x2*)(P + OG_OFF + (size_t)row * 512 + (col0 - 1536) + bj * 128 + n * 16) = wv;
                        }
                }
            return;
        }
        const float scale = (col0 >= 2048 && col0 < 2560) ? 0.125f : 1.f;
        const int ten = (col0 < 1536) ? 2 : (3 + ((col0 - 2048) >> 9));
#pragma unroll
        for (int bj = 0; bj < 2; ++bj)
#pragma unroll
            for (int n = 0; n < 2; ++n) {
                const int c = col0 + bj * 128 + n * 16;
                bf16_t* base = P + hm_off(ten, bb, (c & 511) >> 6, tt0) + (c & 63);
#pragma unroll
                for (int ai = 0; ai < 2; ++ai)
#pragma unroll
                    for (int m = 0; m < 4; ++m) {
                        const f32x4 v = acc[ai][bj][m][n] * scale;
                        u32x2 wv; wv.x = pk2(v.x, v.y); wv.y = pk2(v.z, v.w);
                        *(u32x2*)(base + (size_t)(ai * 128 + m * 16) * 64) = wv;
                    }
            }
    }
};
struct EpiResid {
    const float* xin; float* xout; const float* xcin; float* xcout; const float* g; float* part;
    __device__ __forceinline__ void operator()(f32x4 (&acc)[2][2][4][2], int row0, int col0, int wc, int fq, int slice) const {
        const float* src; float* dst; int b;
        if (row0 < NLAT) { src = xin + (size_t)row0 * D; dst = xout + (size_t)row0 * D; b = row0 >> 12; }
        else { src = xcin + (size_t)(row0 - NLAT) * D; dst = xcout + (size_t)(row0 - NLAT) * D; b = 8; }
        const float* gb = g + b * NMODC + col0;
        f32x4 gv[2][2];
#pragma unroll
        for (int bj = 0; bj < 2; ++bj)
#pragma unroll
            for (int n = 0; n < 2; ++n) gv[bj][n] = *(const f32x4*)(gb + bj * 128 + n * 16);
#pragma unroll
        for (int ai = 0; ai < 2; ++ai) {
            if (slice >= 0) {
#pragma unroll
                for (int m = 0; m < 4; ++m)
#pragma unroll
                    for (int bj = 0; bj < 2; ++bj)
#pragma unroll
                        for (int n = 0; n < 2; ++n)
                            *(f32x4*)(part + (size_t)slice * NCTX * D + (size_t)(row0 - NLAT) * D + (size_t)(ai * 128 + m * 16) * D + col0 + bj * 128 + n * 16) = gv[bj][n] * acc[ai][bj][m][n];
            } else {
                f32x4 xv[4][2][2];
#pragma unroll
                for (int m = 0; m < 4; ++m)
#pragma unroll
                    for (int bj = 0; bj < 2; ++bj)
#pragma unroll
                        for (int n = 0; n < 2; ++n) xv[m][bj][n] = *(const f32x4*)(src + (size_t)(ai * 128 + m * 16) * D + col0 + bj * 128 + n * 16);
#pragma unroll
                for (int m = 0; m < 4; ++m)
#pragma unroll
                    for (int bj = 0; bj < 2; ++bj)
#pragma unroll
                        for (int n = 0; n < 2; ++n) *(f32x4*)(dst + (size_t)(ai * 128 + m * 16) * D + col0 + bj * 128 + n * 16) = xv[m][bj][n] + gv[bj][n] * acc[ai][bj][m][n];
            }
            asm volatile("" ::: "memory");
        }
    }
};
struct EpiRelu2 {
    bf16_t* O;
    __device__ __forceinline__ void operator()(f32x4 (&acc)[2][2][4][2], int row0, int col0, int wc, int fq, int slice) const {
#pragma unroll
        for (int ai = 0; ai < 2; ++ai)
#pragma unroll
            for (int m = 0; m < 4; ++m) {
                const int row = row0 + ai * 128 + m * 16;
#pragma unroll
                for (int bj = 0; bj < 2; ++bj)
#pragma unroll
                    for (int n = 0; n < 2; ++n) {
                        f32x4 v = acc[ai][bj][m][n];
                        v.x = fmaxf(v.x, 0.f); v.y = fmaxf(v.y, 0.f); v.z = fmaxf(v.z, 0.f); v.w = fmaxf(v.w, 0.f);
                        v = v * v;
                        u32x2 wv; wv.x = pk2(v.x, v.y); wv.y = pk2(v.z, v.w);
                        *(u32x2*)(O + (size_t)row * DFF + col0 + bj * 128 + n * 16) = wv;
                    }
            }
    }
};

__device__ __forceinline__ int mrow(int j, int s, int dir, int b) {
    if (j < 4) { const int pos = j * 64 + s; return NLAT + b * CTXL + (dir ? (CTXL - 1 - pos) : pos); }
    const int pos = (j - 4) * 64 + s; return b * SEQ + (dir ? (SEQ - 1 - pos) : pos);
}
__device__ __forceinline__ int mtt(int j, int s, int dir) {
    if (j < 4) { const int pos = j * 64 + s; return SEQ + (dir ? (CTXL - 1 - pos) : pos); }
    const int pos = (j - 4) * 64 + s; return dir ? (SEQ - 1 - pos) : pos;
}
__device__ void mlstm_item(const Params& p, int l, int item, unsigned char* smem) {
    const int dir = item & 1, h = (item >> 1) & 7, b = item >> 4;
    bf16_t* Ks = (bf16_t*)smem;
    bf16_t* KwT = Ks + 64 * LDSS;
    bf16_t* VT0 = KwT + 64 * LDSS;
    bf16_t* Cs0 = VT0 + 2 * 48 * LDSS;
    float* gbA = (float*)(Cs0 + 2 * 48 * LDSS);
    float* gaA = gbA + 68 * 64;
    float* gpA = gaA + 68 * 64;
    const bf16_t* P = (const bf16_t*)(p.ws + WS_PA);
    const float* gates = (const float*)(p.ws + WS_GATES);
    bf16_t* hout = (bf16_t*)(p.ws + WS_HFB) + (size_t)dir * MTOT * 512;
    const int tid = otid(), lane = tid & 63, wid = tid >> 6, w = wid & 3, eh = wid >> 2, fr = lane & 15, fq = lane >> 4;
    bf16_t* VT = VT0 + eh * 48 * LDSS;
    bf16_t* Cs = Cs0 + eh * 48 * LDSS;
    const float big = p.b_gate[l * 32 + dir * 8 + h], bfg = p.b_gate[l * 32 + 16 + dir * 8 + h];
    for (int i = tid; i < 2 * 16 * LDSS; i += NTHR) { const int hh = i / (16 * LDSS), ii = i % (16 * LDSS); VT0[hh * 48 * LDSS + 32 * LDSS + ii] = (ii < LDSS) ? (bf16_t)0x3F80 : (bf16_t)0; }
    for (int i = tid; i < 2 * 48 * LDSS; i += NTHR) Cs0[i] = 0;
    f32x4 Cacc[3];
#pragma unroll
    for (int et = 0; et < 3; ++et) Cacc[et] = (f32x4){0.f, 0.f, 0.f, 0.f};
    float mst = 0.f;
    const int ls = tid >> 3, lpart = tid & 7;
    u32x4 rkA, rvA, rqA0, rqA1, rkB, rvB, rqB0, rqB1;
    {
        rkA = *(const u32x4*)(P + hm_off(1, b, h, mtt(0, ls, dir)) + lpart * 8);
        rvA = *(const u32x4*)(P + hm_off(2, b, h, mtt(0, ls, dir)) + lpart * 8);
        const bf16_t* pq = P + hm_off(0, b, h, mtt(0, w * 16 + fr, dir)) + fq * 8;
        rqA0 = *(const u32x4*)pq; rqA1 = *(const u32x4*)(pq + 32);
        rkB = *(const u32x4*)(P + hm_off(1, b, h, mtt(1, ls, dir)) + lpart * 8);
        rvB = *(const u32x4*)(P + hm_off(2, b, h, mtt(1, ls, dir)) + lpart * 8);
        const bf16_t* pq1 = P + hm_off(0, b, h, mtt(1, w * 16 + fr, dir)) + fq * 8;
        rqB0 = *(const u32x4*)pq1; rqB1 = *(const u32x4*)(pq1 + 32);
    }
    {
        float gi[9], gf[9];
#pragma unroll
        for (int i = 0; i < 9; ++i) {
            const int jj = wid + 8 * i;
            gi[i] = 0.f; gf[i] = 0.f;
            if (jj < 68) { const size_t rg = (size_t)mrow(jj, lane, dir, b) * 32; gi[i] = gates[rg + dir * 8 + h]; gf[i] = gates[rg + 16 + dir * 8 + h]; }
        }
#pragma unroll
        for (int i = 0; i < 9; ++i) {
            const int jj = wid + 8 * i;
            if (jj < 68) {
                const float fg = gf[i] + bfg;
                float v = fminf(fg, 0.f) - log1pf(__expf(-fabsf(fg)));
#pragma unroll
                for (int o = 1; o < 64; o <<= 1) { const float t = __shfl_up(v, o); if (lane >= o) v += t; }
                float a = (gi[i] + big) - v, pm = a;
#pragma unroll
                for (int o = 1; o < 64; o <<= 1) { const float t = __shfl_up(pm, o); if (lane >= o) pm = fmaxf(pm, t); }
                gbA[jj * 64 + lane] = v; gaA[jj * 64 + lane] = a; gpA[jj * 64 + lane] = pm;
            }
        }
    }
    __syncthreads();
    auto step = [&](const int j, u32x4& rk0, u32x4& rv, u32x4& rq0, u32x4& rq1) __attribute__((always_inline)) {
        const bf16x8 qf0 = as_bf16x8(rq0), qf1 = as_bf16x8(rq1);
        const u32x4 k0 = rk0;
        *(u32x4*)(Ks + ls * LDSS + lpart * 8) = k0;
        {
            bf16_t* vd = VT0 + (lpart >> 2) * 48 * LDSS + ((lpart & 3) * 8) * LDSS + ((ls + 8 * (lpart & 3) + 32 * (lpart >> 2)) & 63);
            vd[0 * LDSS] = (bf16_t)(rv.x & 0xffff); vd[1 * LDSS] = (bf16_t)(rv.x >> 16);
            vd[2 * LDSS] = (bf16_t)(rv.y & 0xffff); vd[3 * LDSS] = (bf16_t)(rv.y >> 16);
            vd[4 * LDSS] = (bf16_t)(rv.z & 0xffff); vd[5 * LDSS] = (bf16_t)(rv.z >> 16);
            vd[6 * LDSS] = (bf16_t)(rv.w & 0xffff); vd[7 * LDSS] = (bf16_t)(rv.w >> 16);
        }
        const float* gb = gbA + j * 64; const float* ga = gaA + j * 64; const float* gp = gpA + j * 64;
        const float pm63 = gp[63], bend = gb[63];
        {
            const float wk = __expf(ga[ls] - pm63);
            bf16_t* kd = KwT + (lpart * 8) * LDSS + ((ls + 8 * lpart) & 63);
            kd[0 * LDSS] = f2bf(bflo(k0.x) * wk); kd[1 * LDSS] = f2bf(bfhi(k0.x) * wk);
            kd[2 * LDSS] = f2bf(bflo(k0.y) * wk); kd[3 * LDSS] = f2bf(bfhi(k0.y) * wk);
            kd[4 * LDSS] = f2bf(bflo(k0.z) * wk); kd[5 * LDSS] = f2bf(bfhi(k0.z) * wk);
            kd[6 * LDSS] = f2bf(bflo(k0.w) * wk); kd[7 * LDSS] = f2bf(bfhi(k0.w) * wk);
        }
        if (j + 2 < 68) {
            rk0 = *(const u32x4*)(P + hm_off(1, b, h, mtt(j + 2, ls, dir)) + lpart * 8);
            rv = *(const u32x4*)(P + hm_off(2, b, h, mtt(j + 2, ls, dir)) + lpart * 8);
            const bf16_t* pq = P + hm_off(0, b, h, mtt(j + 2, w * 16 + fr, dir)) + fq * 8;
            rq0 = *(const u32x4*)pq; rq1 = *(const u32x4*)(pq + 32);
        }
        __syncthreads();
        const int t = w * 16 + fr;
        const float pt = gp[t], bt = gb[t];
        bf16x8 pf[2];
        {
            f32x4 sv[4];
#pragma unroll
            for (int st = 0; st < 4; ++st) {
                f32x4 a4 = {0.f, 0.f, 0.f, 0.f};
                a4 = mfma16(*(const bf16x8*)(Ks + (st * 16 + fr) * LDSS + fq * 8), qf0, a4);
                a4 = mfma16(*(const bf16x8*)(Ks + (st * 16 + fr) * LDSS + 32 + fq * 8), qf1, a4);
                const f32x4 av = *(const f32x4*)(ga + st * 16 + fq * 4);
                const int s0 = st * 16 + fq * 4;
                sv[st].x = (s0 + 0 <= t) ? a4.x * __expf(av.x - pt) : 0.f;
                sv[st].y = (s0 + 1 <= t) ? a4.y * __expf(av.y - pt) : 0.f;
                sv[st].z = (s0 + 2 <= t) ? a4.z * __expf(av.z - pt) : 0.f;
                sv[st].w = (s0 + 3 <= t) ? a4.w * __expf(av.w - pt) : 0.f;
            }
#pragma unroll
            for (int k2 = 0; k2 < 2; ++k2) {
                u32x4 u; u.x = pk2(sv[2 * k2].x, sv[2 * k2].y); u.y = pk2(sv[2 * k2].z, sv[2 * k2].w); u.z = pk2(sv[2 * k2 + 1].x, sv[2 * k2 + 1].y); u.w = pk2(sv[2 * k2 + 1].z, sv[2 * k2 + 1].w);
                pf[k2] = as_bf16x8(u);
            }
        }
        const float mx = fmaxf(mst, pt), wprev = __expf(mst - mx), rr = __expf(pt - mx);
        f32x4 num[3];
#pragma unroll
        for (int et = 0; et < 3; ++et) {
            f32x4 apv = {0.f, 0.f, 0.f, 0.f}, aqc = {0.f, 0.f, 0.f, 0.f};
#pragma unroll
            for (int k2 = 0; k2 < 2; ++k2) {
                u32x4 u;
                const int skv = 8 * (et * 2 + (fr >> 3)) + 32 * eh;
                const u32x2 lo = *(const u32x2*)(VT + (et * 16 + fr) * LDSS + ((32 * k2 + fq * 4 + skv) & 63)), hi = *(const u32x2*)(VT + (et * 16 + fr) * LDSS + ((32 * k2 + 16 + fq * 4 + skv) & 63));
                u.x = lo.x; u.y = lo.y; u.z = hi.x; u.w = hi.y;
                apv = mfma16(as_bf16x8(u), pf[k2], apv);
            }
            aqc = mfma16(*(const bf16x8*)(Cs + (et * 16 + fr) * LDSS + fq * 8), qf0, aqc);
            aqc = mfma16(*(const bf16x8*)(Cs + (et * 16 + fr) * LDSS + 32 + fq * 8), qf1, aqc);
            num[et] = aqc * wprev + apv * rr;
        }
        {
            const float qn = __shfl(num[2].x, fr);
            const float den = fmaxf(fabsf(qn), __expf(-(bt + mx)));
            const float inv = 1.0f / den;
            bf16_t* ho = hout + (size_t)mrow(j, t, dir, b) * 512 + h * 64 + eh * 32 + fq * 4;
#pragma unroll
            for (int et = 0; et < 2; ++et) {
                const f32x4 hv = num[et] * inv;
                u32x2 wv; wv.x = pk2(hv.x, hv.y); wv.y = pk2(hv.z, hv.w);
                *(u32x2*)(ho + et * 16) = wv;
            }
        }
        f32x4 dC[3];
#pragma unroll
        for (int et = 0; et < 3; ++et) {
            dC[et] = (f32x4){0.f, 0.f, 0.f, 0.f};
#pragma unroll
            for (int ks = 0; ks < 2; ++ks)
                dC[et] = mfma16(*(const bf16x8*)(KwT + (w * 16 + fr) * LDSS + ((ks * 32 + fq * 8 + 8 * (w * 2 + (fr >> 3))) & 63)), *(const bf16x8*)(VT + (et * 16 + fr) * LDSS + ((ks * 32 + fq * 8 + 8 * (et * 2 + (fr >> 3)) + 32 * eh) & 63)), dC[et]);
        }
        __syncthreads();
        {
            const float mx63 = fmaxf(mst, pm63), wc = __expf(mst - mx63), sc2 = __expf(pm63 - mx63);
#pragma unroll
            for (int et = 0; et < 3; ++et) {
                Cacc[et] = Cacc[et] * wc + dC[et] * sc2;
                u32x2 wv; wv.x = pk2(Cacc[et].x, Cacc[et].y); wv.y = pk2(Cacc[et].z, Cacc[et].w);
                *(u32x2*)(Cs + (et * 16 + fr) * LDSS + w * 16 + fq * 4) = wv;
            }
            mst = bend + mx63;
        }
    };
#pragma unroll 1
    for (int j = 0; j < 68; j += 2) { step(j, rkA, rvA, rqA0, rqA1); step(j + 1, rkB, rvB, rqB0, rqB1); }
}

template <int QABS0, bool LOCAL>
__device__ __forceinline__ void na_chunk(const bf16_t* Ks, const bf16_t* VT, const float* rb, unsigned vmask, const bf16x8 (&qf)[2][2], f32x4 (&O)[4][2], float (&mrun)[2], float (&lrun)[2], int fr, int fq) {
    bf16x8 Kf[4][2];
#pragma unroll
    for (int kt = 0; kt < 4; ++kt)
#pragma unroll
        for (int ks = 0; ks < 2; ++ks) Kf[kt][ks] = *(const bf16x8*)(Ks + (kt * 16 + fr) * LDSS + ks * 32 + fq * 8);
    bf16x8 pf[2][2];
    float alph[2];
#pragma unroll
    for (int qt = 0; qt < 2; ++qt) {
        constexpr int dummy = 0; (void)dummy;
        const int qabs = QABS0 + qt;
        const int klo = LOCAL ? (qabs > 0 ? qabs - 1 : 0) : 0, khi = LOCAL ? (qabs < 3 ? qabs + 1 : 3) : 3;
        const float* rbq = rb - 16 * qabs;
        f32x4 sv[4];
        float mx = -1e30f;
#pragma unroll
        for (int kt = 0; kt < 4; ++kt) {
            if (kt >= klo && kt <= khi) {
                sv[kt] = mfma16(Kf[kt][0], qf[qt][0], (f32x4){0.f, 0.f, 0.f, 0.f});
                sv[kt] = mfma16(Kf[kt][1], qf[qt][1], sv[kt]);
                if (LOCAL) {
                    float bz0 = rbq[16 * kt + 0], bz1 = rbq[16 * kt + 1], bz2 = rbq[16 * kt + 2], bz3 = rbq[16 * kt + 3];
                    asm volatile("" : "+v"(bz0), "+v"(bz1), "+v"(bz2), "+v"(bz3));
                    sv[kt].x = ((vmask >> (qt * 16 + kt * 4 + 0)) & 1u) ? (sv[kt].x + bz0) : -1e30f;
                    sv[kt].y = ((vmask >> (qt * 16 + kt * 4 + 1)) & 1u) ? (sv[kt].y + bz1) : -1e30f;
                    sv[kt].z = ((vmask >> (qt * 16 + kt * 4 + 2)) & 1u) ? (sv[kt].z + bz2) : -1e30f;
                    sv[kt].w = ((vmask >> (qt * 16 + kt * 4 + 3)) & 1u) ? (sv[kt].w + bz3) : -1e30f;
                }
                mx = fmaxf(mx, fmaxf(fmaxf(sv[kt].x, sv[kt].y), fmaxf(sv[kt].z, sv[kt].w)));
            } else sv[kt] = (f32x4){0.f, 0.f, 0.f, 0.f};
        }
        mx = fmaxf(mx, __shfl_xor(mx, 16)); mx = fmaxf(mx, __shfl_xor(mx, 32));
        const float mnew = fmaxf(mrun[qt], mx);
        alph[qt] = __expf(mrun[qt] - mnew);
        mrun[qt] = mnew;
        float ls = 0.f;
#pragma unroll
        for (int kt = 0; kt < 4; ++kt) {
            if (kt >= klo && kt <= khi) {
                sv[kt].x = __expf(sv[kt].x - mnew); sv[kt].y = __expf(sv[kt].y - mnew); sv[kt].z = __expf(sv[kt].z - mnew); sv[kt].w = __expf(sv[kt].w - mnew);
                ls += (sv[kt].x + sv[kt].y) + (sv[kt].z + sv[kt].w);
            }
        }
        lrun[qt] = lrun[qt] * alph[qt] + ls;
#pragma unroll
        for (int k2 = 0; k2 < 2; ++k2) {
            u32x4 u; u.x = pk2(sv[2 * k2].x, sv[2 * k2].y); u.y = pk2(sv[2 * k2].z, sv[2 * k2].w); u.z = pk2(sv[2 * k2 + 1].x, sv[2 * k2 + 1].y); u.w = pk2(sv[2 * k2 + 1].z, sv[2 * k2 + 1].w);
            pf[qt][k2] = as_bf16x8(u);
        }
    }
#pragma unroll
    for (int dt = 0; dt < 4; ++dt) {
        bf16x8 Vf[2];
#pragma unroll
        for (int k2 = 0; k2 < 2; ++k2) {
            const int sk = 8 * (dt * 2 + (fr >> 3));
            const u32x2 lo2 = *(const u32x2*)(VT + (dt * 16 + fr) * LDSS + ((32 * k2 + fq * 4 + sk) & 63)), hi2 = *(const u32x2*)(VT + (dt * 16 + fr) * LDSS + ((32 * k2 + 16 + fq * 4 + sk) & 63));
            u32x4 u; u.x = lo2.x; u.y = lo2.y; u.z = hi2.x; u.w = hi2.y;
            Vf[k2] = as_bf16x8(u);
        }
#pragma unroll
        for (int qt = 0; qt < 2; ++qt) {
            const int qabs = QABS0 + qt;
            const int klo = LOCAL ? (qabs > 0 ? qabs - 1 : 0) : 0, khi = LOCAL ? (qabs < 3 ? qabs + 1 : 3) : 3;
            O[dt][qt] = O[dt][qt] * alph[qt];
            if (klo <= 1) O[dt][qt] = mfma16(Vf[0], pf[qt][0], O[dt][qt]);
            if (khi >= 2) O[dt][qt] = mfma16(Vf[1], pf[qt][1], O[dt][qt]);
        }
    }
}

__device__ void na_item(const Params& p, int l, int item, bool isctx, unsigned char* smem) {
    bf16_t* Ks = (bf16_t*)smem;
    bf16_t* VT = Ks + 64 * LDSS;
    float* rp = (float*)(VT + 64 * LDSS);
    const bf16_t* P = (const bf16_t*)(p.ws + WS_PA);
    bf16_t* Y = (bf16_t*)(p.ws + WS_HB);
    const int tid = otid(), lane = tid & 63, w = tid >> 6, fr = lane & 15, fq = lane >> 4;
    int b, h, rg;
    if (isctx) { rg = 0; h = item & 7; b = item >> 3; } else { rg = item & 15; h = (item >> 4) & 7; b = item >> 7; }
    const int r = rg * 4 + (w >> 1);
    const int qc0 = (w & 1) * 32;
    const int rs = min(max(r - 4, 0), 56);
    const int qrow0 = isctx ? (NLAT + b * CTXL + w * 32) : (b * SEQ + r * 64 + qc0);
    const int qtt0 = isctx ? (SEQ + w * 32) : (r * 64 + qc0);
    bf16x8 qf[2][2];
#pragma unroll
    for (int qt = 0; qt < 2; ++qt)
#pragma unroll
        for (int ks = 0; ks < 2; ++ks) qf[qt][ks] = *(const bf16x8*)(P + hm_off(3, b, h, qtt0 + qt * 16 + fr) + ks * 32 + fq * 8);
    for (int i = tid; i < 15 * 64; i += NTHR) { const int x = (i & 63) - 16; rp[i] = (x >= 0 && x < 31) ? p.rpb[(size_t)(l * 8 + h) * 15 * 31 + (i >> 6) * 31 + x] : 0.f; }
    unsigned vmask = 0u;
#pragma unroll
    for (int qt = 0; qt < 2; ++qt) {
        const int qc = qc0 + qt * 16 + fr, cs = min(max(qc - 8, 0), 48);
#pragma unroll
        for (int kt = 0; kt < 4; ++kt)
#pragma unroll
            for (int jj = 0; jj < 4; ++jj) { const int kc = kt * 16 + fq * 4 + jj; if (kc >= cs && kc < cs + 16) vmask |= 1u << (qt * 16 + kt * 4 + jj); }
    }
    f32x4 O[4][2];
    float mrun[2], lrun[2];
#pragma unroll
    for (int qt = 0; qt < 2; ++qt) {
        mrun[qt] = -1e30f; lrun[qt] = 0.f;
#pragma unroll
        for (int dt = 0; dt < 4; ++dt) O[dt][qt] = (f32x4){0.f, 0.f, 0.f, 0.f};
    }
    const int lo = isctx ? 0 : min(max(rg * 4 - 4, 0), 56);
    const int hi = isctx ? -1 : (min(max(rg * 4 + 3 - 4, 0), 56) + 7);
    const int nloc = hi - lo + 1, nch = nloc + 4;
    const int lkey = tid >> 3, lpart = tid & 7;
    u32x4 rk0, rv0;
    {
        const int ktt0 = (0 < nloc) ? (lo * 64) : SEQ;
        rk0 = *(const u32x4*)(P + hm_off(4, b, h, ktt0 + lkey) + lpart * 8);
        rv0 = *(const u32x4*)(P + hm_off(5, b, h, ktt0 + lkey) + lpart * 8);
    }
#pragma unroll 1
    for (int c = 0; c < nch; ++c) {
        *(u32x4*)(Ks + lkey * LDSS + lpart * 8) = rk0;
        {
            bf16_t* vd = VT + (lpart * 8) * LDSS + ((lkey + 8 * lpart) & 63);
            vd[0 * LDSS] = (bf16_t)(rv0.x & 0xffff); vd[1 * LDSS] = (bf16_t)(rv0.x >> 16);
            vd[2 * LDSS] = (bf16_t)(rv0.y & 0xffff); vd[3 * LDSS] = (bf16_t)(rv0.y >> 16);
            vd[4 * LDSS] = (bf16_t)(rv0.z & 0xffff); vd[5 * LDSS] = (bf16_t)(rv0.z >> 16);
            vd[6 * LDSS] = (bf16_t)(rv0.w & 0xffff); vd[7 * LDSS] = (bf16_t)(rv0.w >> 16);
        }
        if (c + 1 < nch) {
            const int cn = c + 1;
            const int ktt0 = (cn < nloc) ? ((lo + cn) * 64) : (SEQ + (cn - nloc) * 64);
            rk0 = *(const u32x4*)(P + hm_off(4, b, h, ktt0 + lkey) + lpart * 8);
            rv0 = *(const u32x4*)(P + hm_off(5, b, h, ktt0 + lkey) + lpart * 8);
        }
        __syncthreads();
        const bool local = c < nloc;
        const int kr = lo + c;
        const bool active = !local || (kr >= rs && kr < rs + 8);
        if (active) {
            const float* rb = rp + (kr - r + 7) * 64 + 31 + fq * 4 - fr;
            if (!local) na_chunk<0, false>(Ks, VT, rb, vmask, qf, O, mrun, lrun, fr, fq);
            else if (w & 1) na_chunk<2, true>(Ks, VT, rb, vmask, qf, O, mrun, lrun, fr, fq);
            else na_chunk<0, true>(Ks, VT, rb, vmask, qf, O, mrun, lrun, fr, fq);
        }
        __syncthreads();
    }
#pragma unroll
    for (int qt = 0; qt < 2; ++qt) {
        float lt = lrun[qt];
        lt += __shfl_xor(lt, 16); lt += __shfl_xor(lt, 32);
        const float inv = 1.0f / lt;
        bf16_t* yo = Y + (size_t)(qrow0 + qt * 16 + fr) * D + 512 + h * 64 + fq * 4;
#pragma unroll
        for (int dt = 0; dt < 4; ++dt) {
            const f32x4 ov = O[dt][qt] * inv;
            u32x2 wv; wv.x = pk2(ov.x, ov.y); wv.y = pk2(ov.z, ov.w);
            *(u32x2*)(yo + dt * 16) = wv;
        }
    }
}

__device__ void phase_mixers(const Params& p, int l, unsigned char* smem) {
    __shared__ int s_item;
    unsigned* ctr = (unsigned*)(p.ws + WS_CTL) + l;
    const int nitems = 128 + 1024 + ((l < DEPTH - 1) ? 64 : 0);
    for (;;) {
        __syncthreads();
        if (threadIdx.x == 0) s_item = (int)atomicAdd(ctr, 1u);
        __syncthreads();
        const int item = s_item;
        if (item >= nitems) break;
        if (item < 128) { mlstm_item(p, l, item, smem); continue; }
        if (item < 1152) na_item(p, l, item - 128, false, smem);
        else na_item(p, l, item - 1152, true, smem);
    }
}

__device__ void phase_mfinal(const Params& p, int l) {
    const int nrows = (l < DEPTH - 1) ? MTOT : NLAT;
    const bf16_t* P = (const bf16_t*)(p.ws + WS_PA);
    const bf16_t* HF = (const bf16_t*)(p.ws + WS_HFB);
    const bf16_t* HBk = HF + (size_t)MTOT * 512;
    bf16_t* Y = (bf16_t*)(p.ws + WS_HB);
    const float* g = p.mlstm_norm_g + l * 512;
    const int tid = otid(), lane = tid & 63, nw = gridDim.x * NWAVE, c = lane * 8;
    const f32x4 g0 = *(const f32x4*)(g + c), g1 = *(const f32x4*)(g + c + 4);
    const float gg[8] = {g0.x, g0.y, g0.z, g0.w, g1.x, g1.y, g1.z, g1.w};
    for (int row0 = blockIdx.x * NWAVE + (tid >> 6); row0 < nrows; row0 += 4 * nw) {
        u32x4 a[4], bq[4], o[4];
#pragma unroll
        for (int i = 0; i < 4; ++i) {
            const int r = min(row0 + i * nw, nrows - 1);
            a[i] = *(const u32x4*)(HF + (size_t)r * 512 + c); bq[i] = *(const u32x4*)(HBk + (size_t)r * 512 + c); o[i] = *(const u32x4*)(P + OG_OFF + (size_t)r * 512 + c);
        }
#pragma unroll
        for (int i = 0; i < 4; ++i) {
            const int row = row0 + i * nw;
            if (row >= nrows) continue;
            float v[8];
            v[0] = bflo(a[i].x) + bflo(bq[i].x); v[1] = bfhi(a[i].x) + bfhi(bq[i].x); v[2] = bflo(a[i].y) + bflo(bq[i].y); v[3] = bfhi(a[i].y) + bfhi(bq[i].y);
            v[4] = bflo(a[i].z) + bflo(bq[i].z); v[5] = bfhi(a[i].z) + bfhi(bq[i].z); v[6] = bflo(a[i].w) + bflo(bq[i].w); v[7] = bfhi(a[i].w) + bfhi(bq[i].w);
            float s = ((v[0] + v[1]) + (v[2] + v[3])) + ((v[4] + v[5]) + (v[6] + v[7]));
            s += __shfl_xor(s, 1); s += __shfl_xor(s, 2); s += __shfl_xor(s, 4);
            const float mu = s * (1.f / 64.f);
            float q = 0.f;
#pragma unroll
            for (int k = 0; k < 8; ++k) { v[k] -= mu; q += v[k] * v[k]; }
            q += __shfl_xor(q, 1); q += __shfl_xor(q, 2); q += __shfl_xor(q, 4);
            const float rstd = 1.0f / sqrtf(q * (1.f / 64.f) + 1e-6f);
            float ov[8];
            ov[0] = bflo(o[i].x); ov[1] = bfhi(o[i].x); ov[2] = bflo(o[i].y); ov[3] = bfhi(o[i].y); ov[4] = bflo(o[i].z); ov[5] = bfhi(o[i].z); ov[6] = bflo(o[i].w); ov[7] = bfhi(o[i].w);
            float y[8];
#pragma unroll
            for (int k = 0; k < 8; ++k) y[k] = v[k] * rstd * gg[k] / (1.f + __expf(-ov[k]));
            u32x4 wv; wv.x = pk2(y[0], y[1]); wv.y = pk2(y[2], y[3]); wv.z = pk2(y[4], y[5]); wv.w = pk2(y[6], y[7]);
            *(u32x4*)(Y + (size_t)row * D + c) = wv;
        }
    }
}

__device__ void phase_final(const Params& p) {
    const int tid = otid(), lane = tid & 63, nw = gridDim.x * NWAVE;
    for (int row0 = blockIdx.x * NWAVE + (tid >> 6); row0 < NLAT; row0 += 4 * nw) {
        f32x4 v[4][4];
#pragma unroll
        for (int i = 0; i < 4; ++i) {
            const int r = min(row0 + i * nw, NLAT - 1);
#pragma unroll
            for (int j = 0; j < 4; ++j) v[i][j] = ((const f32x4*)(p.out + (size_t)r * D))[lane + 64 * j];
        }
#pragma unroll
        for (int i = 0; i < 4; ++i) {
            const int row = row0 + i * nw;
            if (row >= NLAT) continue;
            float s = 0.f;
#pragma unroll
            for (int j = 0; j < 4; ++j) s += (v[i][j].x * v[i][j].x + v[i][j].y * v[i][j].y) + (v[i][j].z * v[i][j].z + v[i][j].w * v[i][j].w);
            s = wave_sum(s);
            const float rstd = 1.0f / sqrtf(s * (1.f / D) + 1e-6f);
#pragma unroll
            for (int j = 0; j < 4; ++j) {
                const f32x4 gv = *(const f32x4*)(p.final_g + (lane + 64 * j) * 4);
                ((f32x4*)(p.out + (size_t)row * D))[lane + 64 * j] = v[i][j] * rstd * gv;
            }
        }
    }
}

#define XB_TMO      128
#define XB_XCNT(j)  (256  + 64 * (j))
#define XB_XSUB(j)  (1280 + 64 * (j))
#define XB_XGEN(j)  (2304 + 64 * (j))
#define XB_TOP      3328
#define XB_TOPGEN   3392
#define XCD_BAR_WORDS 3456
#define XB_SPIN_CAP (1u << 18)
__device__ __forceinline__ unsigned xb_ld(unsigned* p)              { return __hip_atomic_load(p, __ATOMIC_RELAXED, __HIP_MEMORY_SCOPE_AGENT); }
__device__ __forceinline__ unsigned xb_add(unsigned* p, unsigned v) { return __hip_atomic_fetch_add(p, v, __ATOMIC_RELAXED, __HIP_MEMORY_SCOPE_AGENT); }
__device__ __forceinline__ unsigned xb_xcc_id() { return (unsigned)__builtin_amdgcn_s_getreg((3 << 11) | 20) & 0xFu; }
#define XB_SPIN(cond, bar) do { unsigned _sp = 0; while (cond) { __builtin_amdgcn_s_sleep(1); \
    if ((++_sp & 255u) == 0u) { if (xb_ld(&(bar)[XB_TMO])) break; if (_sp > XB_SPIN_CAP) { atomicAdd(&(bar)[XB_TMO], 1u); break; } } } } while (0)
struct XcdBarrier { unsigned* bar; unsigned x; volatile LAS unsigned* st; };
__device__ __forceinline__ XcdBarrier xcd_barrier_post(unsigned* bar, volatile LAS unsigned* st) {
    XcdBarrier b; b.bar = bar; b.x = xb_xcc_id(); b.st = st;
    if (threadIdx.x == 0) (void)xb_add(&bar[XB_XCNT(b.x)], 1u);
    return b;
}
__device__ __forceinline__ void xcd_barrier_complete(unsigned* bar, unsigned x, unsigned& nloc, unsigned& nx) {
    const unsigned G = gridDim.x * gridDim.y * gridDim.z;
    unsigned sum, cnt, mine, sp = 0u;
    for (;;) {
        sum = 0u; cnt = 0u; mine = 0u;
#pragma unroll
        for (unsigned j = 0; j < 16; ++j) { const unsigned c = xb_ld(&bar[XB_XCNT(j)]); sum += c; cnt += (c > 0u) ? 1u : 0u; mine = (j == x) ? c : mine; }
        if (sum == G) break;
        __builtin_amdgcn_s_sleep(1);
        if ((++sp & 255u) == 0u) { if (xb_ld(&bar[XB_TMO])) break; if (sp > XB_SPIN_CAP) { atomicAdd(&bar[XB_TMO], 1u); break; } }
    }
    nloc = mine > 0u ? mine : 1u; nx = cnt > 0u ? cnt : 1u;
}
__device__ __forceinline__ void xcd_barrier(const XcdBarrier& b) {
    asm volatile("s_waitcnt vmcnt(0)" ::: "memory");
    __syncthreads();
    if (threadIdx.x == 0) {
        unsigned* bar = b.bar;
        __builtin_amdgcn_s_waitcnt(0);
        unsigned nloc = b.st[0], nx = b.st[1];
        if (nloc == 0u) { xcd_barrier_complete(bar, b.x, nloc, nx); b.st[0] = nloc; b.st[1] = nx; }
        const unsigned old = xb_add(&bar[XB_XSUB(b.x)], 1u);
        const unsigned gen = old / nloc;
        if (old + 1u == (gen + 1u) * nloc) {
            __builtin_amdgcn_fence(__ATOMIC_RELEASE, "agent");
            asm volatile("s_waitcnt vmcnt(0)" ::: "memory");
            const unsigned og = xb_add(&bar[XB_TOP], 1u);
            const unsigned tg = og / nx;
            if (og + 1u == (tg + 1u) * nx) xb_add(&bar[XB_TOPGEN], 1u);
            else XB_SPIN(xb_ld(&bar[XB_TOPGEN]) == tg, bar);
            __builtin_amdgcn_fence(__ATOMIC_ACQUIRE, "agent");
            xb_add(&bar[XB_XGEN(b.x)], 1u);
            asm volatile("s_waitcnt vmcnt(0)" ::: "memory");
        } else {
            XB_SPIN(xb_ld(&bar[XB_XGEN(b.x)]) == gen, bar);
            __builtin_amdgcn_fence(__ATOMIC_ACQUIRE, "agent");
            asm volatile("s_waitcnt vmcnt(0)" ::: "memory");
        }
    }
    __syncthreads();
}

__global__ void __launch_bounds__(512) fwd_kernel(Params p) {
    extern __shared__ __attribute__((aligned(16))) unsigned char smem[];
    cg::grid_group grid = cg::this_grid();
    __shared__ __attribute__((aligned(16))) unsigned xb_words[4];
    if (threadIdx.x < 4) xb_words[threadIdx.x] = 0u;
    __syncthreads();
    const XcdBarrier xb = xcd_barrier_post((unsigned*)(p.ws + WS_CTL) + 256, (volatile LAS unsigned*)xb_words);
    int ph = 0;
#define PHASE(...) { if (ph >= p.ph_lo && ph < p.ph_hi) { __VA_ARGS__; if (ph + 1 < p.ph_hi) { if (p.ph_lo < 0) grid.sync(); else xcd_barrier(xb); } } ++ph; }
    PHASE(phase_prologue(p, smem));
    float* xc = (float*)(p.ws + WS_XC);
    bf16_t* HB = (bf16_t*)(p.ws + WS_HB);
    bf16_t* PA = (bf16_t*)(p.ws + WS_PA);
#pragma unroll 1
    for (int l = 0; l < DEPTH; ++l) {
        const float* modl = (const float*)(p.ws + WS_MODS) + (size_t)l * 9 * NMODC;
        const float* xlat = (l == 0) ? p.x : p.out;
        float* xctx = xc;
        const int mrows = (l < DEPTH - 1) ? MTOT : NLAT;
        PHASE({ norm_rows(xlat, xctx, MTOT, p.norm1_g + l * D, modl, 0, D, HB, (const float*)(p.ws + WS_HFB), (l > 0) ? 8 : 0); convert_weights(p, l, smem); });
        PHASE({ EpiInProj e{PA, (float*)(p.ws + WS_GATES), (const float*)(p.ws + WS_ROPE), (const float*)(p.ws + WS_ROPE) + SEQ * 32};
                gemm_phase(HB, (const bf16_t*)(p.ws + WS_WIN), MTOT, DINP, D, e, smem); });
        PHASE(phase_mixers(p, l, smem));
        PHASE(phase_mfinal(p, l));
        PHASE({ EpiResid e{xlat, p.out, xctx, xc, modl + 2 * D, (float*)(p.ws + WS_HFB)};
                gemm_phase(HB, (const bf16_t*)(p.ws + WS_WOUT), mrows, D, D, e, smem, (mrows > NLAT) ? 4 : 1); });
        PHASE(norm_rows(p.out, xc, mrows, p.norm2_g + l * D, modl, 3 * D, 4 * D, HB, (const float*)(p.ws + WS_HFB), 4));
        PHASE({ EpiRelu2 e{PA};
                gemm_phase(HB, (const bf16_t*)(p.ws + WS_W1), mrows, DFF, D, e, smem); });
        PHASE({ EpiResid e{p.out, p.out, xc, xc, modl + 5 * D, (float*)(p.ws + WS_HFB)};
                gemm_phase(PA, (const bf16_t*)(p.ws + WS_W2), mrows, D, DFF, e, smem, (mrows > NLAT) ? 8 : 1); });
    }
    PHASE(phase_final(p));
#undef PHASE
}

constexpr int N_PHASES = 2 + 8 * DEPTH;

extern "C" void kernel_launch(void* const* d_in, const int* in_sizes, int n_in, void* d_out, int out_size, void* d_ws, size_t ws_size, hipStream_t stream) {
    static int grid_blocks = 0;
    if (grid_blocks == 0) {
        if (n_in != 16 || out_size != NLAT * D || ws_size < WS_END) { fprintf(stderr, "kernel_launch: unexpected shapes (n_in %d out %d ws %zu need %zu)\n", n_in, out_size, ws_size, (size_t)WS_END); grid_blocks = -1; return; }
        int dev = 0, cus = 0, per_cu = 0;
        (void)hipGetDevice(&dev);
        (void)hipDeviceGetAttribute(&cus, hipDeviceAttributeMultiprocessorCount, dev);
        (void)hipFuncSetAttribute((const void*)fwd_kernel, hipFuncAttributeMaxDynamicSharedMemorySize, SHM_BYTES);
        (void)hipOccupancyMaxActiveBlocksPerMultiprocessor(&per_cu, (const void*)fwd_kernel, NTHR, SHM_BYTES);
        if (per_cu < 1) per_cu = 1;
        if (per_cu > 1) per_cu = 1;
        grid_blocks = cus * per_cu;
    }
    if (grid_blocks < 0) return;
    (void)hipMemsetAsync((char*)d_ws + WS_CTL, 0, 16384, stream);
    Params p{};
    p.x = (const float*)d_in[0]; p.c = (const float*)d_in[1]; p.ctx = (const float*)d_in[2]; p.c_ctx = (const float*)d_in[3];
    p.w_ada = (const float*)d_in[4]; p.b_ada = (const float*)d_in[5]; p.norm1_g = (const float*)d_in[6]; p.w_in = (const float*)d_in[7];
    p.b_gate = (const float*)d_in[8]; p.mlstm_norm_g = (const float*)d_in[9]; p.rpb = (const float*)d_in[10]; p.w_out = (const float*)d_in[11];
    p.norm2_g = (const float*)d_in[12]; p.w_mlp1 = (const float*)d_in[13]; p.w_mlp2 = (const float*)d_in[14]; p.final_g = (const float*)d_in[15];
    p.out = (float*)d_out; p.ws = (unsigned char*)d_ws;
#if defined(MULTI_LAUNCH)
    for (int ph = 0; ph < N_PHASES; ++ph) {
        p.ph_lo = ph; p.ph_hi = ph + 1;
        hipLaunchKernelGGL(fwd_kernel, dim3(grid_blocks), dim3(NTHR), SHM_BYTES, stream, p);
    }
#else
    p.ph_lo = 0; p.ph_hi = N_PHASES;
    void* args[] = {&p};
    hipError_t e = hipLaunchCooperativeKernel((const void*)fwd_kernel, dim3(grid_blocks), dim3(NTHR), args, SHM_BYTES, stream);
    if (e != hipSuccess) fprintf(stderr, "cooperative launch failed: %s (grid %d)\n", hipGetErrorString(e), grid_blocks);
#endif
}
```

```cpp
#include <hip/hip_runtime.h>
#include <hip/hip_cooperative_groups.h>
#include <cstdio>
#include <cstdint>
namespace cg = cooperative_groups;

typedef unsigned short bf16_t;
typedef short bf16x8 __attribute__((ext_vector_type(8)));
typedef float f32x4 __attribute__((ext_vector_type(4)));
typedef unsigned u32x4 __attribute__((ext_vector_type(4)));
typedef unsigned u32x2 __attribute__((ext_vector_type(2)));

constexpr int D = 1024, NB = 8, SEQ = 4096, DEPTH = 4, CTXL = 256;
constexpr int DIN = 3616, DINP = 3840, PW = 3584, DFF = 4096;
constexpr int NLAT = NB * SEQ, NCTX = NB * CTXL, MTOT = NLAT + NCTX;
constexpr int NMODC = 6 * D;
constexpr int LDSS = 72;
constexpr int NTHR = 512, NWAVE = 8;
constexpr int SHM_BYTES = 131072;

constexpr size_t WS_CTL = 0;
constexpr size_t WS_MODS = 16384;
constexpr size_t WS_ROPE = WS_MODS + (size_t)DEPTH * 9 * NMODC * 4;
constexpr size_t WS_GATES = WS_ROPE + (size_t)2 * SEQ * 32 * 4;
constexpr size_t WS_XC = WS_GATES + (size_t)MTOT * 32 * 4;
constexpr size_t WS_WIN = WS_XC + (size_t)NCTX * D * 4;
constexpr size_t WS_WOUT = WS_WIN + (size_t)DINP * D * 2;
constexpr size_t WS_W1 = WS_WOUT + (size_t)D * D * 2;
constexpr size_t WS_W2 = WS_W1 + (size_t)DFF * D * 2;
constexpr size_t WS_HB = WS_W2 + (size_t)DFF * D * 2;
constexpr size_t WS_HFB = WS_HB + (size_t)MTOT * D * 2;
constexpr size_t WS_PA = WS_HFB + (size_t)2 * MTOT * 512 * 2;
constexpr size_t WS_END = WS_PA + (size_t)MTOT * DFF * 2;
static_assert(WS_ROPE % 256 == 0 && WS_GATES % 256 == 0 && WS_XC % 256 == 0 && WS_WIN % 256 == 0 && WS_HB % 256 == 0 && WS_HFB % 256 == 0 && WS_PA % 256 == 0, "align");

constexpr int TPB = SEQ + CTXL;
constexpr size_t HM_T = (size_t)NB * 8 * TPB * 64;
constexpr size_t OG_OFF = 6 * HM_T;
static_assert(OG_OFF + (size_t)MTOT * 512 == (size_t)MTOT * PW, "layout");
__device__ __forceinline__ size_t hm_off(int ten, int b, int h, int tt) { return (size_t)ten * HM_T + ((size_t)(b * 8 + h) * TPB + tt) * 64; }

struct Params {
    const float *x, *c, *ctx, *c_ctx, *w_ada, *b_ada, *norm1_g, *w_in, *b_gate, *mlstm_norm_g, *rpb, *w_out, *norm2_g, *w_mlp1, *w_mlp2, *final_g;
    float* out;
    unsigned char* ws;
    int ph_lo, ph_hi;
};

__device__ __forceinline__ unsigned pk2(float lo, float hi) { unsigned r; asm("v_cvt_pk_bf16_f32 %0, %1, %2" : "=v"(r) : "v"(lo), "v"(hi)); return r; }
__device__ __forceinline__ bf16_t f2bf(float f) { return (bf16_t)(pk2(f, 0.f) & 0xffffu); }
__device__ __forceinline__ float bf2f(unsigned v) { return __uint_as_float(v << 16); }
__device__ __forceinline__ float bflo(unsigned w) { return __uint_as_float(w << 16); }
__device__ __forceinline__ float bfhi(unsigned w) { return __uint_as_float(w & 0xffff0000u); }
__device__ __forceinline__ float wave_sum(float v) {
#pragma unroll
    for (int o = 1; o < 64; o <<= 1) v += __shfl_xor(v, o);
    return v;
}
__device__ __forceinline__ int otid() { int t = threadIdx.x; asm volatile("" : "+v"(t)); return t; }
__device__ __forceinline__ f32x4 mfma16(bf16x8 a, bf16x8 b, f32x4 c) { return __builtin_amdgcn_mfma_f32_16x16x32_bf16(a, b, c, 0, 0, 0); }
__device__ __forceinline__ bf16x8 as_bf16x8(u32x4 v) { return __builtin_bit_cast(bf16x8, v); }

__device__ void phase_prologue(const Params& p, unsigned char* smem) {
    float* sl = (float*)smem;
    float* red = sl + 9 * 1024;
    const int tid = otid();
    {
        float* cosT = (float*)(p.ws + WS_ROPE);
        float* sinT = cosT + SEQ * 32;
        for (int i = blockIdx.x * NTHR + tid; i < SEQ * 32; i += gridDim.x * NTHR) {
            const int t = i >> 5, dp = i & 31;
            const float pos = (dp < 16) ? (float)(t >> 6) : (float)(t & 63);
            const float inv = exp2f(-(float)(dp & 15) * (13.287712379549449f / 16.f));
            const float ang = pos * inv;
            cosT[i] = __cosf(ang);
            sinT[i] = __sinf(ang);
        }
    }
    {
        const f32x4* src = (const f32x4*)p.ctx; f32x4* dst = (f32x4*)(p.ws + WS_XC);
        for (int i = blockIdx.x * NTHR + tid; i < NCTX * D / 4; i += gridDim.x * NTHR) dst[i] = src[i];
    }
    if (blockIdx.x >= DEPTH * 96) return;
    for (int i = tid; i < 9 * 1024; i += NTHR) {
        const int r = i >> 10, k = i & 1023;
        const float v = (r < 8) ? p.c[r * 1024 + k] : p.c_ctx[k];
        sl[i] = v / (1.f + __expf(-v));
    }
    __syncthreads();
    float* mods = (float*)(p.ws + WS_MODS);
    for (int item = blockIdx.x; item < DEPTH * 96; item += gridDim.x) {
        const int l = item / 96, cb = item % 96, cl = tid & 63, kg = tid >> 6;
        const float* w = p.w_ada + (size_t)l * D * NMODC + cb * 64 + cl;
        float acc[9];
#pragma unroll
        for (int r = 0; r < 9; ++r) acc[r] = 0.f;
#pragma unroll 32
        for (int k = kg * 128; k < kg * 128 + 128; ++k) {
            const float wv = w[(size_t)k * NMODC];
#pragma unroll
            for (int r = 0; r < 9; ++r) acc[r] += sl[r * 1024 + k] * wv;
        }
#pragma unroll
        for (int r = 0; r < 9; ++r) red[(kg * 9 + r) * 64 + cl] = acc[r];
        __syncthreads();
        for (int i = tid; i < 9 * 64; i += NTHR) {
            const int r = i >> 6, c2 = i & 63;
            float s = 0.f;
#pragma unroll
            for (int g8 = 0; g8 < 8; ++g8) s += red[(g8 * 9 + r) * 64 + c2];
            mods[(size_t)(l * 9 + r) * NMODC + cb * 64 + c2] = s + p.b_ada[l * NMODC + cb * 64 + c2];
        }
        __syncthreads();
    }
}

__device__ __forceinline__ void norm_store_row(const f32x4 (&v)[4], int row, int b, int lane, const float* g, const float* modl, int sh_off, int sc_off, bf16_t* outp) {
    float s = 0.f;
#pragma unroll
    for (int j = 0; j < 4; ++j) s += (v[j].x * v[j].x + v[j].y * v[j].y) + (v[j].z * v[j].z + v[j].w * v[j].w);
    s = wave_sum(s);
    const float rstd = 1.0f / sqrtf(s * (1.f / D) + 1e-6f);
    const float* sh = modl + b * NMODC + sh_off;
    const float* sc = modl + b * NMODC + sc_off;
#pragma unroll
    for (int j = 0; j < 4; ++j) {
        const int col = (lane + 64 * j) * 4;
        const f32x4 gv = *(const f32x4*)(g + col), scv = *(const f32x4*)(sc + col), shv = *(const f32x4*)(sh + col);
        const f32x4 o = (v[j] * rstd * gv) * (1.f + scv) + shv;
        u32x2 wv; wv.x = pk2(o.x, o.y); wv.y = pk2(o.z, o.w);
        *(u32x2*)(outp + (size_t)row * D + col) = wv;
    }
}
__device__ void norm_rows(const float* xlat, float* xctx, int nrows, const float* g, const float* modl, int sh_off, int sc_off, bf16_t* outp, const float* part, int npart) {
    const int tid = otid(), lane = tid & 63;
    const int nw = gridDim.x * NWAVE, w0 = blockIdx.x * NWAVE + (tid >> 6);
    for (int row = w0; row < NLAT; row += 4 * nw) {
        f32x4 v[4][4];
#pragma unroll
        for (int i = 0; i < 4; ++i) {
            const int r = min(row + i * nw, NLAT - 1);
#pragma unroll
            for (int j = 0; j < 4; ++j) v[i][j] = ((const f32x4*)(xlat + (size_t)r * D))[lane + 64 * j];
        }
#pragma unroll
        for (int i = 0; i < 4; ++i) {
            const int r = row + i * nw;
            if (r < NLAT) norm_store_row(v[i], r, r >> 12, lane, g, modl, sh_off, sc_off, outp);
        }
    }
    for (int row = NLAT + w0; row < nrows; row += nw) {
        const float* xr = xctx + (size_t)(row - NLAT) * D;
        f32x4 v[4];
#pragma unroll
        for (int j = 0; j < 4; ++j) v[j] = ((const f32x4*)xr)[lane + 64 * j];
        if (npart > 0) {
            for (int sl = 0; sl < npart; ++sl) {
                const f32x4* pr = (const f32x4*)(part + (size_t)sl * NCTX * D + (size_t)(row - NLAT) * D);
#pragma unroll
                for (int j = 0; j < 4; ++j) v[j] += pr[lane + 64 * j];
            }
#pragma unroll
            for (int j = 0; j < 4; ++j) ((f32x4*)(xctx + (size_t)(row - NLAT) * D))[lane + 64 * j] = v[j];
        }
        norm_store_row(v, row, 8, lane, g, modl, sh_off, sc_off, outp);
    }
}

__device__ __forceinline__ int rope_perm(int n) { return ((n >> 5) & 1) * 16 + (n & 15) + 32 * ((n >> 4) & 1); }
__device__ __forceinline__ void transpose_item(const float* W, int K, int N, bf16_t* WT, int kt, int nt, float* tile, int nperm) {
    const int tid = otid(), k0 = kt * 64, n0 = nt * 64;
    {
        const int r = tid >> 4, c4 = (tid & 15) * 4;
#pragma unroll
        for (int ps = 0; ps < 2; ++ps) {
            const int k = ps * 32 + r;
            f32x4 v = {0.f, 0.f, 0.f, 0.f};
            int lc = n0 + c4;
            if (nperm == -2) { const int p0 = (n0 & 255) + (c4 & 32); lc = (n0 & ~255) + ((p0 >> 5) & 3) * 64 + (p0 >> 7) * 32 + (c4 & 31); }
            if (lc < N) v = *(const f32x4*)(W + (size_t)(k0 + k) * N + lc);
            tile[k * 65 + c4 + 0] = v.x; tile[k * 65 + c4 + 1] = v.y; tile[k * 65 + c4 + 2] = v.z; tile[k * 65 + c4 + 3] = v.w;
        }
    }
    __syncthreads();
    {
        const int kg = tid & 7, n = tid >> 3;
        const int nl = (nperm < 0) ? ((n & 32) + 8 * ((n & 15) >> 2) + 4 * ((n >> 4) & 1) + (n & 3)) : n;
        const float* s = tile + (kg * 8) * 65 + nl;
        u32x4 o; o.x = pk2(s[0], s[65]); o.y = pk2(s[2 * 65], s[3 * 65]); o.z = pk2(s[4 * 65], s[5 * 65]); o.w = pk2(s[6 * 65], s[7 * 65]);
        *(u32x4*)(WT + (size_t)(n0 + n) * K + k0 + kg * 8) = o;
    }
    __syncthreads();
}
__device__ void convert_weights(const Params& p, int l, unsigned char* smem) {
    float* tile = (float*)smem;
    constexpr int I_IN = 16 * (DINP / 64), I_OUT = 16 * 16, I_1 = 16 * 64, I_2 = 64 * 16;
    for (int it = blockIdx.x; it < I_IN + I_OUT + I_1 + I_2; it += gridDim.x) {
        int r = it;
        if (r < I_IN) { const int n0i = (r / 16) * 64; transpose_item(p.w_in + (size_t)l * D * DIN, D, DIN, (bf16_t*)(p.ws + WS_WIN), r % 16, r / 16, tile, n0i < 1024 ? -2 : (n0i < PW ? -1 : 0)); continue; }
        r -= I_IN;
        if (r < I_OUT) { transpose_item(p.w_out + (size_t)l * D * D, D, D, (bf16_t*)(p.ws + WS_WOUT), r % 16, r / 16, tile, 0); continue; }
        r -= I_OUT;
        if (r < I_1) { transpose_item(p.w_mlp1 + (size_t)l * D * DFF, D, DFF, (bf16_t*)(p.ws + WS_W1), r % 16, r / 16, tile, -1); continue; }
        r -= I_1;
        transpose_item(p.w_mlp2 + (size_t)l * DFF * D, DFF, D, (bf16_t*)(p.ws + WS_W2), r % 64, r / 64, tile, 0);
    }
}

constexpr int G_BM = 256, G_BK = 64, G_HALF = 128, G_HT = G_HALF * G_BK;
__device__ __forceinline__ int lds_byte(int r, int c) { const int st = (r >> 4) * 2 + (c >> 5), rr = r & 15, cc = c & 31, ob = rr * 64 + cc * 2; return st * 1024 + (ob ^ (((ob >> 9) & 1) << 5)); }
__device__ __forceinline__ void stage_rc(int b, int& R, int& C) { const int st = b / 1024, sb = b % 1024, swz = sb ^ (((sb >> 9) & 1) << 5); R = (st >> 1) * 16 + swz / 64; C = (st & 1) * 32 + (swz % 64) / 2; }
#define LAS __attribute__((address_space(3)))
template <class Epi>
__device__ __forceinline__ void gemm_phase(const bf16_t* __restrict__ A, const bf16_t* __restrict__ Bt, int M, int N, int K, const Epi& epi, unsigned char* smem, int S = 1) {
    LAS unsigned char* lds = (LAS unsigned char*)smem;
    const int tid = otid(), wid = __builtin_amdgcn_readfirstlane(tid >> 6), lane = tid & 63, wr = wid >> 2, wc = wid & 3, fr = lane & 15, fq = lane >> 4;
    unsigned voff[2];
#pragma unroll
    for (int i = 0; i < 2; ++i) { int R, C; stage_rc(tid * 16 + i * 8192, R, C); voff[i] = (unsigned)(R * K + C) * 2u; }
    const size_t hstep = (size_t)G_HALF * K * 2;
    const unsigned ldsw = (unsigned)wid * 1024u;
    const int aoff = lds_byte(wr * 64 + fr, fq * 8), boff = lds_byte(wc * 32 + fr, fq * 8);
#define SA(b, h) (((b) * 2 + (h)) * 16384)
#define SB(b, h) ((4 + (b) * 2 + (h)) * 16384)
#define STAGE(bufoff, gbase) do { _Pragma("unroll") for (int _i = 0; _i < 2; ++_i) \
      __builtin_amdgcn_global_load_lds((const unsigned*)((const char*)(gbase) + voff[_i]), (LAS unsigned*)(lds + (bufoff) + ldsw + _i * 8192), 16, 0, 0); } while (0)
#define LDA(dst, b, h) do { _Pragma("unroll") for (int m = 0; m < 4; ++m) _Pragma("unroll") for (int k = 0; k < 2; ++k) dst[m][k] = *(const LAS bf16x8*)(lds + SA(b, h) + aoff + m * 2048 + k * 1024); } while (0)
#define LDB(dst, b, h) do { _Pragma("unroll") for (int n = 0; n < 2; ++n) _Pragma("unroll") for (int k = 0; k < 2; ++k) dst[n][k] = *(const LAS bf16x8*)(lds + SB(b, h) + boff + n * 2048 + k * 1024); } while (0)
#define MMA(ai, bj, At_, Bt_) do { __builtin_amdgcn_s_setprio(1); \
    _Pragma("unroll") for (int m = 0; m < 4; ++m) _Pragma("unroll") for (int n = 0; n < 2; ++n) _Pragma("unroll") for (int k = 0; k < 2; ++k) \
      acc[ai][bj][m][n] = __builtin_amdgcn_mfma_f32_16x16x32_bf16(Bt_[n][k], At_[m][k], acc[ai][bj][m][n], 0, 0, 0); \
    __builtin_amdgcn_s_setprio(0); } while (0)
#define WAIT_V(n) asm volatile("s_waitcnt vmcnt(" #n ")" ::: "memory")
#define WAIT_L(n) asm volatile("s_waitcnt lgkmcnt(" #n ")" ::: "memory")
#define BAR __builtin_amdgcn_s_barrier()
#define SCHED __builtin_amdgcn_sched_barrier(0)
    const int nM = M / G_BM, nN = N / G_BM, nMf = (S > 1) ? (NLAT / G_BM) : nM, nwg = nMf * nN, nsp = (nM - nMf) * nN * S, ksl = K / S;
    auto unit = [&](int round, int& brow, int& bcol, int& k0) __attribute__((always_inline)) -> bool {
        int wgid = round * (int)gridDim.x + (int)blockIdx.x;
        if (wgid >= nwg + nsp) return false;
        if (wgid >= nwg) { const int r = wgid - nwg, tl = r / S; k0 = (r - tl * S) * ksl; brow = (nMf + tl % (nM - nMf)) * G_BM; bcol = (tl / (nM - nMf)) * G_BM; return true; }
        { const int q = nwg / 8, r = nwg % 8, xcd = wgid % 8, off = wgid / 8; wgid = (xcd < r ? xcd * (q + 1) : r * (q + 1) + (xcd - r) * q) + off; }
        const int nig = 8 * nN, gid = wgid / nig, fm = gid * 8, gsz = min(nMf - fm, 8);
        brow = (fm + ((wgid % nig) % gsz)) * G_BM; bcol = ((wgid % nig) / gsz) * G_BM; k0 = 0;
        return true;
    };
    int ui = 0, brow, bcol, k0;
    if (!unit(0, brow, bcol, k0)) return;
    const char* cA = (const char*)A + ((size_t)brow * K + k0) * 2;
    const char* cB = (const char*)Bt + ((size_t)bcol * K + k0) * 2;
    f32x4 acc[2][2][4][2];
#pragma unroll
    for (int a0 = 0; a0 < 2; ++a0)
#pragma unroll
        for (int a1 = 0; a1 < 2; ++a1)
#pragma unroll
            for (int a2 = 0; a2 < 4; ++a2)
#pragma unroll
                for (int a3 = 0; a3 < 2; ++a3) acc[a0][a1][a2][a3] = (f32x4){0.f, 0.f, 0.f, 0.f};
    bf16x8 At[4][2], B0[2][2], B1[2][2];
    STAGE(SB(0, 0), cB); STAGE(SB(0, 1), cB + hstep); STAGE(SA(0, 0), cA); STAGE(SA(0, 1), cA + hstep);
    if (wr == 1) BAR;
    WAIT_V(2); BAR;
    STAGE(SB(1, 0), cB + 128); STAGE(SA(1, 0), cA + 128); STAGE(SB(1, 1), cB + hstep + 128);
    WAIT_V(6); BAR;
#pragma unroll 1
    for (;;) {
        int nbrow = 0, nbcol = 0, nk0 = 0;
        const bool has_next = unit(ui + 1, nbrow, nbcol, nk0);
        const bool split = brow >= nMf * G_BM;
        const int nt = (split ? ksl : K) / G_BK;
        const char* nA = has_next ? (const char*)A + ((size_t)nbrow * K + nk0) * 2 : cA;
        const char* nB = has_next ? (const char*)Bt + ((size_t)nbcol * K + nk0) * 2 : cB;
#pragma unroll 1
        for (int t = 0; t < nt; t += 2) {
            const bool last = (t == nt - 2);
            const char* a1 = cA + (size_t)(t + 1) * 128;
            const char* a2 = last ? nA : cA + (size_t)(t + 2) * 128; const char* b2 = last ? nB : cB + (size_t)(t + 2) * 128;
            const char* a3 = a2 + 128; const char* b3 = b2 + 128;
            LDB(B0, 0, 0); LDB(B1, 0, 1); SCHED; LDA(At, 0, 0); STAGE(SA(1, 1), a1 + hstep);
            WAIT_V(8); WAIT_L(0); BAR; MMA(0, 0, At, B0); MMA(0, 1, At, B1); BAR; SCHED;
            LDA(At, 0, 1); STAGE(SB(0, 0), b2); STAGE(SB(0, 1), b2 + hstep); STAGE(SA(0, 0), a2);
            WAIT_V(8); WAIT_L(0); BAR; MMA(1, 0, At, B0); MMA(1, 1, At, B1); BAR; SCHED;
            LDB(B0, 1, 0); LDB(B1, 1, 1); SCHED; LDA(At, 1, 0); STAGE(SA(0, 1), a2 + hstep);
            WAIT_V(8); WAIT_L(0); BAR; MMA(0, 0, At, B0); MMA(0, 1, At, B1); BAR; SCHED;
            LDA(At, 1, 1); STAGE(SB(1, 0), b3); STAGE(SB(1, 1), b3 + hstep); STAGE(SA(1, 0), a3);
            WAIT_V(8); WAIT_L(0); BAR; MMA(1, 0, At, B0); MMA(1, 1, At, B1); BAR; SCHED;
        }
        if (wr == 0) BAR;
        epi(acc, brow + wr * 64 + fr, bcol + wc * 32 + fq * 4, wc, fq, split ? k0 / ksl : -1);
        if (!has_next) break;
#pragma unroll
        for (int a0 = 0; a0 < 2; ++a0)
#pragma unroll
            for (int a1 = 0; a1 < 2; ++a1)
#pragma unroll
                for (int a2 = 0; a2 < 4; ++a2)
#pragma unroll
                    for (int a3 = 0; a3 < 2; ++a3) acc[a0][a1][a2][a3] = (f32x4){0.f, 0.f, 0.f, 0.f};
        cA = nA; cB = nB; brow = nbrow; bcol = nbcol; k0 = nk0; ++ui;
        if (wr == 1) BAR;
    }
    WAIT_V(0);
    BAR;
#undef SA
#undef SB
#undef STAGE
#undef LDA
#undef LDB
#undef MMA
#undef WAIT_V
#undef WAIT_L
#undef BAR
#undef SCHED
}

struct EpiInProj {
    bf16_t* P; float* gates; const float* cosT; const float* sinT;
    __device__ __forceinline__ void operator()(f32x4 (&acc)[2][2][4][2], int row0, int col0, int wc, int fq, int slice) const {
        if (col0 >= PW) {
            if (wc == 0) {
#pragma unroll
                for (int ai = 0; ai < 2; ++ai)
#pragma unroll
                    for (int m = 0; m < 4; ++m) {
                        const int row = row0 + ai * 128 + m * 16;
#pragma unroll
                        for (int n = 0; n < 2; ++n) *(f32x4*)(gates + (size_t)row * 32 + n * 16 + fq * 4) = acc[ai][0][m][n];
                    }
            }
            return;
        }
        const bool lat = row0 < NLAT;
        const int bb = lat ? (row0 >> 12) : ((row0 - NLAT) >> 8);
        const int tt0 = lat ? (row0 & (SEQ - 1)) : (SEQ + ((row0 - NLAT) & (CTXL - 1)));
        const int tb = col0 - wc * 32 - fq * 4;
        if (col0 < 1024) {
            const float scale = (col0 < 512) ? 0.125f : 1.f;
            const int c = tb + wc * 64;
            bf16_t* base = P + hm_off(c >> 9, bb, (c & 511) >> 6, tt0) + 8 * fq;
#pragma unroll
            for (int ai = 0; ai < 2; ++ai)
#pragma unroll
                for (int m = 0; m < 4; ++m) {
                    const int dr = ai * 128 + m * 16;
                    f32x4 x1[2], x2[2];
#pragma unroll
                    for (int n = 0; n < 2; ++n) {
                        x1[n] = acc[ai][0][m][n]; x2[n] = acc[ai][1][m][n];
                        if (lat) {
                            const int t = tt0 + dr;
                            const f32x4 c4 = *(const f32x4*)(cosT + t * 32 + 8 * fq + 4 * n), s4 = *(const f32x4*)(sinT + t * 32 + 8 * fq + 4 * n);
                            const f32x4 y1 = x1[n] * c4 - x2[n] * s4, y2 = x1[n] * s4 + x2[n] * c4;
                            x1[n] = y1; x2[n] = y2;
                        }
                        x1[n] = x1[n] * scale; x2[n] = x2[n] * scale;
                    }
                    u32x4 w1; w1.x = pk2(x1[0].x, x1[0].y); w1.y = pk2(x1[0].z, x1[0].w); w1.z = pk2(x1[1].x, x1[1].y); w1.w = pk2(x1[1].z, x1[1].w);
                    u32x4 w2; w2.x = pk2(x2[0].x, x2[0].y); w2.y = pk2(x2[0].z, x2[0].w); w2.z = pk2(x2[1].x, x2[1].y); w2.w = pk2(x2[1].z, x2[1].w);
                    *(u32x4*)(base + (size_t)dr * 64) = w1;
                    *(u32x4*)(base + (size_t)dr * 64 + 32) = w2;
                }
            return;
        }
        const int colp = col0 + 4 * fq;
        if (col0 >= 1536 && col0 < 2048) {
#pragma unroll
            for (int ai = 0; ai < 2; ++ai)
#pragma unroll
                for (int m = 0; m < 4; ++m) {
                    const int row = row0 + ai * 128 + m * 16;
#pragma unroll
                    for (int bj = 0; bj < 2; ++bj) {
                        const f32x4 v0 = acc[ai][bj][m][0], v1 = acc[ai][bj][m][1];
                        u32x4 wv; wv.x = pk2(v0.x, v0.y); wv.y = pk2(v0.z, v0.w); wv.z = pk2(v1.x, v1.y); wv.w = pk2(v1.z, v1.w);
                        *(u32x4*)(P + OG_OFF + (size_t)row * 512 + (colp - 1536) + bj * 128) = wv;
                    }
                }
            return;
        }
        const float scale = (col0 >= 2048 && col0 < 2560) ? 0.125f : 1.f;
        const int ten = (col0 < 1536) ? 2 : (3 + ((col0 - 2048) >> 9));
#pragma unroll
        for (int bj = 0; bj < 2; ++bj) {
            const int c = colp + bj * 128;
            bf16_t* base = P + hm_off(ten, bb, (c & 511) >> 6, tt0) + (c & 63);
#pragma unroll
            for (int ai = 0; ai < 2; ++ai)
#pragma unroll
                for (int m = 0; m < 4; ++m) {
                    const f32x4 v0 = acc[ai][bj][m][0] * scale, v1 = acc[ai][bj][m][1] * scale;
                    u32x4 wv; wv.x = pk2(v0.x, v0.y); wv.y = pk2(v0.z, v0.w); wv.z = pk2(v1.x, v1.y); wv.w = pk2(v1.z, v1.w);
                    *(u32x4*)(base + (size_t)(ai * 128 + m * 16) * 64) = wv;
                }
        }
    }
};
struct EpiResid {
    const float* xin; float* xout; const float* xcin; float* xcout; const float* g; float* part;
    __device__ __forceinline__ void operator()(f32x4 (&acc)[2][2][4][2], int row0, int col0, int wc, int fq, int slice) const {
        const float* src; float* dst; int b;
        if (row0 < NLAT) { src = xin + (size_t)row0 * D; dst = xout + (size_t)row0 * D; b = row0 >> 12; }
        else { src = xcin + (size_t)(row0 - NLAT) * D; dst = xcout + (size_t)(row0 - NLAT) * D; b = 8; }
        const float* gb = g + b * NMODC + col0;
        f32x4 gv[2][2];
#pragma unroll
        for (int bj = 0; bj < 2; ++bj)
#pragma unroll
            for (int n = 0; n < 2; ++n) gv[bj][n] = *(const f32x4*)(gb + bj * 128 + n * 16);
#pragma unroll
        for (int ai = 0; ai < 2; ++ai) {
            if (slice >= 0) {
#pragma unroll
                for (int m = 0; m < 4; ++m)
#pragma unroll
                    for (int bj = 0; bj < 2; ++bj)
#pragma unroll
                        for (int n = 0; n < 2; ++n)
                            *(f32x4*)(part + (size_t)slice * NCTX * D + (size_t)(row0 - NLAT) * D + (size_t)(ai * 128 + m * 16) * D + col0 + bj * 128 + n * 16) = gv[bj][n] * acc[ai][bj][m][n];
            } else {
                f32x4 xv[4][2][2];
#pragma unroll
                for (int m = 0; m < 4; ++m)
#pragma unroll
                    for (int bj = 0; bj < 2; ++bj)
#pragma unroll
                        for (int n = 0; n < 2; ++n) xv[m][bj][n] = *(const f32x4*)(src + (size_t)(ai * 128 + m * 16) * D + col0 + bj * 128 + n * 16);
#pragma unroll
                for (int m = 0; m < 4; ++m)
#pragma unroll
                    for (int bj = 0; bj < 2; ++bj)
#pragma unroll
                        for (int n = 0; n < 2; ++n) *(f32x4*)(dst + (size_t)(ai * 128 + m * 16) * D + col0 + bj * 128 + n * 16) = xv[m][bj][n] + gv[bj][n] * acc[ai][bj][m][n];
            }
            asm volatile("" ::: "memory");
        }
    }
};
struct EpiRelu2 {
    bf16_t* O;
    __device__ __forceinline__ void operator()(f32x4 (&acc)[2][2][4][2], int row0, int col0, int wc, int fq, int slice) const {
        const int colp = col0 + 4 * fq;
#pragma unroll
        for (int ai = 0; ai < 2; ++ai)
#pragma unroll
            for (int m = 0; m < 4; ++m) {
                const int row = row0 + ai * 128 + m * 16;
#pragma unroll
                for (int bj = 0; bj < 2; ++bj) {
                    f32x4 v0 = acc[ai][bj][m][0], v1 = acc[ai][bj][m][1];
                    v0.x = fmaxf(v0.x, 0.f); v0.y = fmaxf(v0.y, 0.f); v0.z = fmaxf(v0.z, 0.f); v0.w = fmaxf(v0.w, 0.f);
                    v1.x = fmaxf(v1.x, 0.f); v1.y = fmaxf(v1.y, 0.f); v1.z = fmaxf(v1.z, 0.f); v1.w = fmaxf(v1.w, 0.f);
                    v0 = v0 * v0; v1 = v1 * v1;
                    u32x4 wv; wv.x = pk2(v0.x, v0.y); wv.y = pk2(v0.z, v0.w); wv.z = pk2(v1.x, v1.y); wv.w = pk2(v1.z, v1.w);
                    *(u32x4*)(O + (size_t)row * DFF + colp + bj * 128) = wv;
                }
            }
    }
};

__device__ __forceinline__ int mrow(int j, int s, int dir, int b) {
    if (j < 4) { const int pos = j * 64 + s; return NLAT + b * CTXL + (dir ? (CTXL - 1 - pos) : pos); }
    const int pos = (j - 4) * 64 + s; return b * SEQ + (dir ? (SEQ - 1 - pos) : pos);
}
__device__ __forceinline__ int mtt(int j, int s, int dir) {
    if (j < 4) { const int pos = j * 64 + s; return SEQ + (dir ? (CTXL - 1 - pos) : pos); }
    const int pos = (j - 4) * 64 + s; return dir ? (SEQ - 1 - pos) : pos;
}
__device__ void mlstm_item(const Params& p, int l, int item, unsigned char* smem) {
    const int dir = item & 1, h = (item >> 1) & 7, b = item >> 4;
    bf16_t* Ks = (bf16_t*)smem;
    bf16_t* KwT = Ks + 64 * LDSS;
    bf16_t* VT0 = KwT + 64 * LDSS;
    bf16_t* Cs0 = VT0 + 2 * 48 * LDSS;
    float* gbA = (float*)(Cs0 + 2 * 48 * LDSS);
    float* gaA = gbA + 68 * 64;
    float* gpA = gaA + 68 * 64;
    const bf16_t* P = (const bf16_t*)(p.ws + WS_PA);
    const float* gates = (const float*)(p.ws + WS_GATES);
    bf16_t* hout = (bf16_t*)(p.ws + WS_HFB) + (size_t)dir * MTOT * 512;
    const int tid = otid(), lane = tid & 63, wid = tid >> 6, w = wid & 3, eh = wid >> 2, fr = lane & 15, fq = lane >> 4;
    bf16_t* VT = VT0 + eh * 48 * LDSS;
    bf16_t* Cs = Cs0 + eh * 48 * LDSS;
    const float big = p.b_gate[l * 32 + dir * 8 + h], bfg = p.b_gate[l * 32 + 16 + dir * 8 + h];
    for (int i = tid; i < 2 * 16 * LDSS; i += NTHR) { const int hh = i / (16 * LDSS), ii = i % (16 * LDSS); VT0[hh * 48 * LDSS + 32 * LDSS + ii] = (ii < LDSS) ? (bf16_t)0x3F80 : (bf16_t)0; }
    for (int i = tid; i < 2 * 48 * LDSS; i += NTHR) Cs0[i] = 0;
    f32x4 Cacc[3];
#pragma unroll
    for (int et = 0; et < 3; ++et) Cacc[et] = (f32x4){0.f, 0.f, 0.f, 0.f};
    float mst = 0.f;
    const int ls = tid >> 3, lpart = tid & 7;
    u32x4 rkA, rvA, rqA0, rqA1, rkB, rvB, rqB0, rqB1;
    {
        rkA = *(const u32x4*)(P + hm_off(1, b, h, mtt(0, ls, dir)) + lpart * 8);
        rvA = *(const u32x4*)(P + hm_off(2, b, h, mtt(0, ls, dir)) + lpart * 8);
        const bf16_t* pq = P + hm_off(0, b, h, mtt(0, w * 16 + fr, dir)) + fq * 8;
        rqA0 = *(const u32x4*)pq; rqA1 = *(const u32x4*)(pq + 32);
        rkB = *(const u32x4*)(P + hm_off(1, b, h, mtt(1, ls, dir)) + lpart * 8);
        rvB = *(const u32x4*)(P + hm_off(2, b, h, mtt(1, ls, dir)) + lpart * 8);
        const bf16_t* pq1 = P + hm_off(0, b, h, mtt(1, w * 16 + fr, dir)) + fq * 8;
        rqB0 = *(const u32x4*)pq1; rqB1 = *(const u32x4*)(pq1 + 32);
    }
    {
        float gi[9], gf[9];
#pragma unroll
        for (int i = 0; i < 9; ++i) {
            const int jj = wid + 8 * i;
            gi[i] = 0.f; gf[i] = 0.f;
            if (jj < 68) { const size_t rg = (size_t)mrow(jj, lane, dir, b) * 32; gi[i] = gates[rg + dir * 8 + h]; gf[i] = gates[rg + 16 + dir * 8 + h]; }
        }
#pragma unroll
        for (int i = 0; i < 9; ++i) {
            const int jj = wid + 8 * i;
            if (jj < 68) {
                const float fg = gf[i] + bfg;
                float v = fminf(fg, 0.f) - log1pf(__expf(-fabsf(fg)));
#pragma unroll
                for (int o = 1; o < 64; o <<= 1) { const float t = __shfl_up(v, o); if (lane >= o) v += t; }
                float a = (gi[i] + big) - v, pm = a;
#pragma unroll
                for (int o = 1; o < 64; o <<= 1) { const float t = __shfl_up(pm, o); if (lane >= o) pm = fmaxf(pm, t); }
                gbA[jj * 64 + lane] = v; gaA[jj * 64 + lane] = a; gpA[jj * 64 + lane] = pm;
            }
        }
    }
    __syncthreads();
    auto step = [&](const int j, u32x4& rk0, u32x4& rv, u32x4& rq0, u32x4& rq1) __attribute__((always_inline)) {
        const bf16x8 qf0 = as_bf16x8(rq0), qf1 = as_bf16x8(rq1);
        const u32x4 k0 = rk0;
        *(u32x4*)(Ks + ls * LDSS + lpart * 8) = k0;
        {
            bf16_t* vd = VT0 + (lpart >> 2) * 48 * LDSS + ((lpart & 3) * 8) * LDSS + ((ls + 8 * (lpart & 3) + 32 * (lpart >> 2)) & 63);
            vd[0 * LDSS] = (bf16_t)(rv.x & 0xffff); vd[1 * LDSS] = (bf16_t)(rv.x >> 16);
            vd[2 * LDSS] = (bf16_t)(rv.y & 0xffff); vd[3 * LDSS] = (bf16_t)(rv.y >> 16);
            vd[4 * LDSS] = (bf16_t)(rv.z & 0xffff); vd[5 * LDSS] = (bf16_t)(rv.z >> 16);
            vd[6 * LDSS] = (bf16_t)(rv.w & 0xffff); vd[7 * LDSS] = (bf16_t)(rv.w >> 16);
        }
        const float* gb = gbA + j * 64; const float* ga = gaA + j * 64; const float* gp = gpA + j * 64;
        const float pm63 = gp[63], bend = gb[63];
        {
            const float wk = __expf(ga[ls] - pm63);
            bf16_t* kd = KwT + (lpart * 8) * LDSS + ((ls + 8 * lpart) & 63);
            kd[0 * LDSS] = f2bf(bflo(k0.x) * wk); kd[1 * LDSS] = f2bf(bfhi(k0.x) * wk);
            kd[2 * LDSS] = f2bf(bflo(k0.y) * wk); kd[3 * LDSS] = f2bf(bfhi(k0.y) * wk);
            kd[4 * LDSS] = f2bf(bflo(k0.z) * wk); kd[5 * LDSS] = f2bf(bfhi(k0.z) * wk);
            kd[6 * LDSS] = f2bf(bflo(k0.w) * wk); kd[7 * LDSS] = f2bf(bfhi(k0.w) * wk);
        }
        if (j + 2 < 68) {
            rk0 = *(const u32x4*)(P + hm_off(1, b, h, mtt(j + 2, ls, dir)) + lpart * 8);
            rv = *(const u32x4*)(P + hm_off(2, b, h, mtt(j + 2, ls, dir)) + lpart * 8);
            const bf16_t* pq = P + hm_off(0, b, h, mtt(j + 2, w * 16 + fr, dir)) + fq * 8;
            rq0 = *(const u32x4*)pq; rq1 = *(const u32x4*)(pq + 32);
        }
        __syncthreads();
        const int t = w * 16 + fr;
        const float pt = gp[t], bt = gb[t];
        bf16x8 pf[2];
        {
            f32x4 sv[4];
#pragma unroll
            for (int st = 0; st < 4; ++st) {
                f32x4 a4 = {0.f, 0.f, 0.f, 0.f};
                a4 = mfma16(*(const bf16x8*)(Ks + (st * 16 + fr) * LDSS + fq * 8), qf0, a4);
                a4 = mfma16(*(const bf16x8*)(Ks + (st * 16 + fr) * LDSS + 32 + fq * 8), qf1, a4);
                const f32x4 av = *(const f32x4*)(ga + st * 16 + fq * 4);
                const int s0 = st * 16 + fq * 4;
                sv[st].x = (s0 + 0 <= t) ? a4.x * __expf(av.x - pt) : 0.f;
                sv[st].y = (s0 + 1 <= t) ? a4.y * __expf(av.y - pt) : 0.f;
                sv[st].z = (s0 + 2 <= t) ? a4.z * __expf(av.z - pt) : 0.f;
                sv[st].w = (s0 + 3 <= t) ? a4.w * __expf(av.w - pt) : 0.f;
            }
#pragma unroll
            for (int k2 = 0; k2 < 2; ++k2) {
                u32x4 u; u.x = pk2(sv[2 * k2].x, sv[2 * k2].y); u.y = pk2(sv[2 * k2].z, sv[2 * k2].w); u.z = pk2(sv[2 * k2 + 1].x, sv[2 * k2 + 1].y); u.w = pk2(sv[2 * k2 + 1].z, sv[2 * k2 + 1].w);
                pf[k2] = as_bf16x8(u);
            }
        }
        const float mx = fmaxf(mst, pt), wprev = __expf(mst - mx), rr = __expf(pt - mx);
        f32x4 num[3];
#pragma unroll
        for (int et = 0; et < 3; ++et) {
            f32x4 apv = {0.f, 0.f, 0.f, 0.f}, aqc = {0.f, 0.f, 0.f, 0.f};
#pragma unroll
            for (int k2 = 0; k2 < 2; ++k2) {
                u32x4 u;
                const int skv = 8 * (et * 2 + (fr >> 3)) + 32 * eh;
                const u32x2 lo = *(const u32x2*)(VT + (et * 16 + fr) * LDSS + ((32 * k2 + fq * 4 + skv) & 63)), hi = *(const u32x2*)(VT + (et * 16 + fr) * LDSS + ((32 * k2 + 16 + fq * 4 + skv) & 63));
                u.x = lo.x; u.y = lo.y; u.z = hi.x; u.w = hi.y;
                apv = mfma16(as_bf16x8(u), pf[k2], apv);
            }
            aqc = mfma16(*(const bf16x8*)(Cs + (et * 16 + fr) * LDSS + fq * 8), qf0, aqc);
            aqc = mfma16(*(const bf16x8*)(Cs + (et * 16 + fr) * LDSS + 32 + fq * 8), qf1, aqc);
            num[et] = aqc * wprev + apv * rr;
        }
        {
            const float qn = __shfl(num[2].x, fr);
            const float den = fmaxf(fabsf(qn), __expf(-(bt + mx)));
            const float inv = 1.0f / den;
            bf16_t* ho = hout + (size_t)mrow(j, t, dir, b) * 512 + h * 64 + eh * 32 + fq * 4;
#pragma unroll
            for (int et = 0; et < 2; ++et) {
                const f32x4 hv = num[et] * inv;
                u32x2 wv; wv.x = pk2(hv.x, hv.y); wv.y = pk2(hv.z, hv.w);
                *(u32x2*)(ho + et * 16) = wv;
            }
        }
        f32x4 dC[3];
#pragma unroll
        for (int et = 0; et < 3; ++et) {
            dC[et] = (f32x4){0.f, 0.f, 0.f, 0.f};
#pragma unroll
            for (int ks = 0; ks < 2; ++ks)
                dC[et] = mfma16(*(const bf16x8*)(KwT + (w * 16 + fr) * LDSS + ((ks * 32 + fq * 8 + 8 * (w * 2 + (fr >> 3))) & 63)), *(const bf16x8*)(VT + (et * 16 + fr) * LDSS + ((ks * 32 + fq * 8 + 8 * (et * 2 + (fr >> 3)) + 32 * eh) & 63)), dC[et]);
        }
        __syncthreads();
        {
            const float mx63 = fmaxf(mst, pm63), wc = __expf(mst - mx63), sc2 = __expf(pm63 - mx63);
#pragma unroll
            for (int et = 0; et < 3; ++et) {
                Cacc[et] = Cacc[et] * wc + dC[et] * sc2;
                u32x2 wv; wv.x = pk2(Cacc[et].x, Cacc[et].y); wv.y = pk2(Cacc[et].z, Cacc[et].w);
                *(u32x2*)(Cs + (et * 16 + fr) * LDSS + w * 16 + fq * 4) = wv;
            }
            mst = bend + mx63;
        }
    };
#pragma unroll 1
    for (int j = 0; j < 68; j += 2) { step(j, rkA, rvA, rqA0, rqA1); step(j + 1, rkB, rvB, rqB0, rqB1); }
}

template <int QABS0, bool LOCAL>
__device__ __forceinline__ void na_chunk(const bf16_t* Ks, const bf16_t* VT, const float* rb, unsigned vmask, const bf16x8 (&qf)[2][2], f32x4 (&O)[4][2], float (&mrun)[2], float (&lrun)[2], int fr, int fq) {
    bf16x8 Kf[4][2];
#pragma unroll
    for (int kt = 0; kt < 4; ++kt)
#pragma unroll
        for (int ks = 0; ks < 2; ++ks) Kf[kt][ks] = *(const bf16x8*)(Ks + (kt * 16 + fr) * LDSS + ks * 32 + fq * 8);
    bf16x8 pf[2][2];
    float alph[2];
#pragma unroll
    for (int qt = 0; qt < 2; ++qt) {
        constexpr int dummy = 0; (void)dummy;
        const int qabs = QABS0 + qt;
        const int klo = LOCAL ? (qabs > 0 ? qabs - 1 : 0) : 0, khi = LOCAL ? (qabs < 3 ? qabs + 1 : 3) : 3;
        const float* rbq = rb - 16 * qabs;
        f32x4 sv[4];
        float mx = -1e30f;
#pragma unroll
        for (int kt = 0; kt < 4; ++kt) {
            if (kt >= klo && kt <= khi) {
                sv[kt] = mfma16(Kf[kt][0], qf[qt][0], (f32x4){0.f, 0.f, 0.f, 0.f});
                sv[kt] = mfma16(Kf[kt][1], qf[qt][1], sv[kt]);
                if (LOCAL) {
                    float bz0 = rbq[16 * kt + 0], bz1 = rbq[16 * kt + 1], bz2 = rbq[16 * kt + 2], bz3 = rbq[16 * kt + 3];
                    asm volatile("" : "+v"(bz0), "+v"(bz1), "+v"(bz2), "+v"(bz3));
                    sv[kt].x = ((vmask >> (qt * 16 + kt * 4 + 0)) & 1u) ? (sv[kt].x + bz0) : -1e30f;
                    sv[kt].y = ((vmask >> (qt * 16 + kt * 4 + 1)) & 1u) ? (sv[kt].y + bz1) : -1e30f;
                    sv[kt].z = ((vmask >> (qt * 16 + kt * 4 + 2)) & 1u) ? (sv[kt].z + bz2) : -1e30f;
                    sv[kt].w = ((vmask >> (qt * 16 + kt * 4 + 3)) & 1u) ? (sv[kt].w + bz3) : -1e30f;
                }
                mx = fmaxf(mx, fmaxf(fmaxf(sv[kt].x, sv[kt].y), fmaxf(sv[kt].z, sv[kt].w)));
            } else sv[kt] = (f32x4){0.f, 0.f, 0.f, 0.f};
        }
        mx = fmaxf(mx, __shfl_xor(mx, 16)); mx = fmaxf(mx, __shfl_xor(mx, 32));
        const float mnew = fmaxf(mrun[qt], mx);
        alph[qt] = __expf(mrun[qt] - mnew);
        mrun[qt] = mnew;
        float ls = 0.f;
#pragma unroll
        for (int kt = 0; kt < 4; ++kt) {
            if (kt >= klo && kt <= khi) {
                sv[kt].x = __expf(sv[kt].x - mnew); sv[kt].y = __expf(sv[kt].y - mnew); sv[kt].z = __expf(sv[kt].z - mnew); sv[kt].w = __expf(sv[kt].w - mnew);
                ls += (sv[kt].x + sv[kt].y) + (sv[kt].z + sv[kt].w);
            }
        }
        lrun[qt] = lrun[qt] * alph[qt] + ls;
#pragma unroll
        for (int k2 = 0; k2 < 2; ++k2) {
            u32x4 u; u.x = pk2(sv[2 * k2].x, sv[2 * k2].y); u.y = pk2(sv[2 * k2].z, sv[2 * k2].w); u.z = pk2(sv[2 * k2 + 1].x, sv[2 * k2 + 1].y); u.w = pk2(sv[2 * k2 + 1].z, sv[2 * k2 + 1].w);
            pf[qt][k2] = as_bf16x8(u);
        }
    }
#pragma unroll
    for (int dt = 0; dt < 4; ++dt) {
        bf16x8 Vf[2];
#pragma unroll
        for (int k2 = 0; k2 < 2; ++k2) {
            const int sk = 8 * (dt * 2 + (fr >> 3));
            const u32x2 lo2 = *(const u32x2*)(VT + (dt * 16 + fr) * LDSS + ((32 * k2 + fq * 4 + sk) & 63)), hi2 = *(const u32x2*)(VT + (dt * 16 + fr) * LDSS + ((32 * k2 + 16 + fq * 4 + sk) & 63));
            u32x4 u; u.x = lo2.x; u.y = lo2.y; u.z = hi2.x; u.w = hi2.y;
            Vf[k2] = as_bf16x8(u);
        }
#pragma unroll
        for (int qt = 0; qt < 2; ++qt) {
            const int qabs = QABS0 + qt;
            const int klo = LOCAL ? (qabs > 0 ? qabs - 1 : 0) : 0, khi = LOCAL ? (qabs < 3 ? qabs + 1 : 3) : 3;
            O[dt][qt] = O[dt][qt] * alph[qt];
            if (klo <= 1) O[dt][qt] = mfma16(Vf[0], pf[qt][0], O[dt][qt]);
            if (khi >= 2) O[dt][qt] = mfma16(Vf[1], pf[qt][1], O[dt][qt]);
        }
    }
}

__device__ void na_item(const Params& p, int l, int item, bool isctx, unsigned char* smem) {
    bf16_t* Ks = (bf16_t*)smem;
    bf16_t* VT = Ks + 64 * LDSS;
    float* rp = (float*)(VT + 64 * LDSS);
    const bf16_t* P = (const bf16_t*)(p.ws + WS_PA);
    bf16_t* Y = (bf16_t*)(p.ws + WS_HB);
    const int tid = otid(), lane = tid & 63, w = tid >> 6, fr = lane & 15, fq = lane >> 4;
    int b, h, rg;
    if (isctx) { rg = 0; h = item & 7; b = item >> 3; } else { rg = item & 15; h = (item >> 4) & 7; b = item >> 7; }
    const int r = rg * 4 + (w >> 1);
    const int qc0 = (w & 1) * 32;
    const int rs = min(max(r - 4, 0), 56);
    const int qrow0 = isctx ? (NLAT + b * CTXL + w * 32) : (b * SEQ + r * 64 + qc0);
    const int qtt0 = isctx ? (SEQ + w * 32) : (r * 64 + qc0);
    bf16x8 qf[2][2];
#pragma unroll
    for (int qt = 0; qt < 2; ++qt)
#pragma unroll
        for (int ks = 0; ks < 2; ++ks) qf[qt][ks] = *(const bf16x8*)(P + hm_off(3, b, h, qtt0 + qt * 16 + fr) + ks * 32 + fq * 8);
    for (int i = tid; i < 15 * 64; i += NTHR) { const int x = (i & 63) - 16; rp[i] = (x >= 0 && x < 31) ? p.rpb[(size_t)(l * 8 + h) * 15 * 31 + (i >> 6) * 31 + x] : 0.f; }
    unsigned vmask = 0u;
#pragma unroll
    for (int qt = 0; qt < 2; ++qt) {
        const int qc = qc0 + qt * 16 + fr, cs = min(max(qc - 8, 0), 48);
#pragma unroll
        for (int kt = 0; kt < 4; ++kt)
#pragma unroll
            for (int jj = 0; jj < 4; ++jj) { const int kc = kt * 16 + fq * 4 + jj; if (kc >= cs && kc < cs + 16) vmask |= 1u << (qt * 16 + kt * 4 + jj); }
    }
    f32x4 O[4][2];
    float mrun[2], lrun[2];
#pragma unroll
    for (int qt = 0; qt < 2; ++qt) {
        mrun[qt] = -1e30f; lrun[qt] = 0.f;
#pragma unroll
        for (int dt = 0; dt < 4; ++dt) O[dt][qt] = (f32x4){0.f, 0.f, 0.f, 0.f};
    }
    const int lo = isctx ? 0 : min(max(rg * 4 - 4, 0), 56);
    const int hi = isctx ? -1 : (min(max(rg * 4 + 3 - 4, 0), 56) + 7);
    const int nloc = hi - lo + 1, nch = nloc + 4;
    const int lkey = tid >> 3, lpart = tid & 7;
    u32x4 rk0, rv0;
    {
        const int ktt0 = (0 < nloc) ? (lo * 64) : SEQ;
        rk0 = *(const u32x4*)(P + hm_off(4, b, h, ktt0 + lkey) + lpart * 8);
        rv0 = *(const u32x4*)(P + hm_off(5, b, h, ktt0 + lkey) + lpart * 8);
    }
#pragma unroll 1
    for (int c = 0; c < nch; ++c) {
        *(u32x4*)(Ks + lkey * LDSS + lpart * 8) = rk0;
        {
            bf16_t* vd = VT + (lpart * 8) * LDSS + ((lkey + 8 * lpart) & 63);
            vd[0 * LDSS] = (bf16_t)(rv0.x & 0xffff); vd[1 * LDSS] = (bf16_t)(rv0.x >> 16);
            vd[2 * LDSS] = (bf16_t)(rv0.y & 0xffff); vd[3 * LDSS] = (bf16_t)(rv0.y >> 16);
            vd[4 * LDSS] = (bf16_t)(rv0.z & 0xffff); vd[5 * LDSS] = (bf16_t)(rv0.z >> 16);
            vd[6 * LDSS] = (bf16_t)(rv0.w & 0xffff); vd[7 * LDSS] = (bf16_t)(rv0.w >> 16);
        }
        if (c + 1 < nch) {
            const int cn = c + 1;
            const int ktt0 = (cn < nloc) ? ((lo + cn) * 64) : (SEQ + (cn - nloc) * 64);
            rk0 = *(const u32x4*)(P + hm_off(4, b, h, ktt0 + lkey) + lpart * 8);
            rv0 = *(const u32x4*)(P + hm_off(5, b, h, ktt0 + lkey) + lpart * 8);
        }
        __syncthreads();
        const bool local = c < nloc;
        const int kr = lo + c;
        const bool active = !local || (kr >= rs && kr < rs + 8);
        if (active) {
            const float* rb = rp + (kr - r + 7) * 64 + 31 + fq * 4 - fr;
            if (!local) na_chunk<0, false>(Ks, VT, rb, vmask, qf, O, mrun, lrun, fr, fq);
            else if (w & 1) na_chunk<2, true>(Ks, VT, rb, vmask, qf, O, mrun, lrun, fr, fq);
            else na_chunk<0, true>(Ks, VT, rb, vmask, qf, O, mrun, lrun, fr, fq);
        }
        __syncthreads();
    }
#pragma unroll
    for (int qt = 0; qt < 2; ++qt) {
        float lt = lrun[qt];
        lt += __shfl_xor(lt, 16); lt += __shfl_xor(lt, 32);
        const float inv = 1.0f / lt;
        bf16_t* yo = Y + (size_t)(qrow0 + qt * 16 + fr) * D + 512 + h * 64 + fq * 4;
#pragma unroll
        for (int dt = 0; dt < 4; ++dt) {
            const f32x4 ov = O[dt][qt] * inv;
            u32x2 wv; wv.x = pk2(ov.x, ov.y); wv.y = pk2(ov.z, ov.w);
            *(u32x2*)(yo + dt * 16) = wv;
        }
    }
}

__device__ void phase_mixers(const Params& p, int l, unsigned char* smem) {
    __shared__ int s_item;
    unsigned* ctr = (unsigned*)(p.ws + WS_CTL) + l;
    const int nitems = 128 + 1024 + ((l < DEPTH - 1) ? 64 : 0);
    for (;;) {
        __syncthreads();
        if (threadIdx.x == 0) s_item = (int)atomicAdd(ctr, 1u);
        __syncthreads();
        const int item = s_item;
        if (item >= nitems) break;
        if (item < 128) { mlstm_item(p, l, item, smem); continue; }
        if (item < 1152) na_item(p, l, item - 128, false, smem);
        else na_item(p, l, item - 1152, true, smem);
    }
}

__device__ void phase_mfinal(const Params& p, int l) {
    const int nrows = (l < DEPTH - 1) ? MTOT : NLAT;
    const bf16_t* P = (const bf16_t*)(p.ws + WS_PA);
    const bf16_t* HF = (const bf16_t*)(p.ws + WS_HFB);
    const bf16_t* HBk = HF + (size_t)MTOT * 512;
    bf16_t* Y = (bf16_t*)(p.ws + WS_HB);
    const float* g = p.mlstm_norm_g + l * 512;
    const int tid = otid(), lane = tid & 63, nw = gridDim.x * NWAVE, c = lane * 8;
    const f32x4 g0 = *(const f32x4*)(g + c), g1 = *(const f32x4*)(g + c + 4);
    const float gg[8] = {g0.x, g0.y, g0.z, g0.w, g1.x, g1.y, g1.z, g1.w};
    for (int row0 = blockIdx.x * NWAVE + (tid >> 6); row0 < nrows; row0 += 4 * nw) {
        u32x4 a[4], bq[4], o[4];
#pragma unroll
        for (int i = 0; i < 4; ++i) {
            const int r = min(row0 + i * nw, nrows - 1);
            a[i] = *(const u32x4*)(HF + (size_t)r * 512 + c); bq[i] = *(const u32x4*)(HBk + (size_t)r * 512 + c); o[i] = *(const u32x4*)(P + OG_OFF + (size_t)r * 512 + c);
        }
#pragma unroll
        for (int i = 0; i < 4; ++i) {
            const int row = row0 + i * nw;
            if (row >= nrows) continue;
            float v[8];
            v[0] = bflo(a[i].x) + bflo(bq[i].x); v[1] = bfhi(a[i].x) + bfhi(bq[i].x); v[2] = bflo(a[i].y) + bflo(bq[i].y); v[3] = bfhi(a[i].y) + bfhi(bq[i].y);
            v[4] = bflo(a[i].z) + bflo(bq[i].z); v[5] = bfhi(a[i].z) + bfhi(bq[i].z); v[6] = bflo(a[i].w) + bflo(bq[i].w); v[7] = bfhi(a[i].w) + bfhi(bq[i].w);
            float s = ((v[0] + v[1]) + (v[2] + v[3])) + ((v[4] + v[5]) + (v[6] + v[7]));
            s += __shfl_xor(s, 1); s += __shfl_xor(s, 2); s += __shfl_xor(s, 4);
            const float mu = s * (1.f / 64.f);
            float q = 0.f;
#pragma unroll
            for (int k = 0; k < 8; ++k) { v[k] -= mu; q += v[k] * v[k]; }
            q += __shfl_xor(q, 1); q += __shfl_xor(q, 2); q += __shfl_xor(q, 4);
            const float rstd = 1.0f / sqrtf(q * (1.f / 64.f) + 1e-6f);
            float ov[8];
            ov[0] = bflo(o[i].x); ov[1] = bfhi(o[i].x); ov[2] = bflo(o[i].y); ov[3] = bfhi(o[i].y); ov[4] = bflo(o[i].z); ov[5] = bfhi(o[i].z); ov[6] = bflo(o[i].w); ov[7] = bfhi(o[i].w);
            float y[8];
#pragma unroll
            for (int k = 0; k < 8; ++k) y[k] = v[k] * rstd * gg[k] / (1.f + __expf(-ov[k]));
            u32x4 wv; wv.x = pk2(y[0], y[1]); wv.y = pk2(y[2], y[3]); wv.z = pk2(y[4], y[5]); wv.w = pk2(y[6], y[7]);
            *(u32x4*)(Y + (size_t)row * D + c) = wv;
        }
    }
}

__device__ void phase_final(const Params& p) {
    const int tid = otid(), lane = tid & 63, nw = gridDim.x * NWAVE;
    for (int row0 = blockIdx.x * NWAVE + (tid >> 6); row0 < NLAT; row0 += 4 * nw) {
        f32x4 v[4][4];
#pragma unroll
        for (int i = 0; i < 4; ++i) {
            const int r = min(row0 + i * nw, NLAT - 1);
#pragma unroll
            for (int j = 0; j < 4; ++j) v[i][j] = ((const f32x4*)(p.out + (size_t)r * D))[lane + 64 * j];
        }
#pragma unroll
        for (int i = 0; i < 4; ++i) {
            const int row = row0 + i * nw;
            if (row >= NLAT) continue;
            float s = 0.f;
#pragma unroll
            for (int j = 0; j < 4; ++j) s += (v[i][j].x * v[i][j].x + v[i][j].y * v[i][j].y) + (v[i][j].z * v[i][j].z + v[i][j].w * v[i][j].w);
            s = wave_sum(s);
            const float rstd = 1.0f / sqrtf(s * (1.f / D) + 1e-6f);
#pragma unroll
            for (int j = 0; j < 4; ++j) {
                const f32x4 gv = *(const f32x4*)(p.final_g + (lane + 64 * j) * 4);
                ((f32x4*)(p.out + (size_t)row * D))[lane + 64 * j] = v[i][j] * rstd * gv;
            }
        }
    }
}

#define XB_TMO      128
#define XB_XCNT(j)  (256  + 64 * (j))
#define XB_XSUB(j)  (1280 + 64 * (j))
#define XB_XGEN(j)  (2304 + 64 * (j))
#define XB_TOP      3328
#define XB_TOPGEN   3392
#define XCD_BAR_WORDS 3456
#define XB_SPIN_CAP (1u << 18)
__device__ __forceinline__ unsigned xb_ld(unsigned* p)              { return __hip_atomic_load(p, __ATOMIC_RELAXED, __HIP_MEMORY_SCOPE_AGENT); }
__device__ __forceinline__ unsigned xb_add(unsigned* p, unsigned v) { return __hip_atomic_fetch_add(p, v, __ATOMIC_RELAXED, __HIP_MEMORY_SCOPE_AGENT); }
__device__ __forceinline__ unsigned xb_xcc_id() { return (unsigned)__builtin_amdgcn_s_getreg((3 << 11) | 20) & 0xFu; }
#define XB_SPIN(cond, bar) do { unsigned _sp = 0; while (cond) { __builtin_amdgcn_s_sleep(1); \
    if ((++_sp & 255u) == 0u) { if (xb_ld(&(bar)[XB_TMO])) break; if (_sp > XB_SPIN_CAP) { atomicAdd(&(bar)[XB_TMO], 1u); break; } } } } while (0)
struct XcdBarrier { unsigned* bar; unsigned x; volatile LAS unsigned* st; };
__device__ __forceinline__ XcdBarrier xcd_barrier_post(unsigned* bar, volatile LAS unsigned* st) {
    XcdBarrier b; b.bar = bar; b.x = xb_xcc_id(); b.st = st;
    if (threadIdx.x == 0) (void)xb_add(&bar[XB_XCNT(b.x)], 1u);
    return b;
}
__device__ __forceinline__ void xcd_barrier_complete(unsigned* bar, unsigned x, unsigned& nloc, unsigned& nx) {
    const unsigned G = gridDim.x * gridDim.y * gridDim.z;
    unsigned sum, cnt, mine, sp = 0u;
    for (;;) {
        sum = 0u; cnt = 0u; mine = 0u;
#pragma unroll
        for (unsigned j = 0; j < 16; ++j) { const unsigned c = xb_ld(&bar[XB_XCNT(j)]); sum += c; cnt += (c > 0u) ? 1u : 0u; mine = (j == x) ? c : mine; }
        if (sum == G) break;
        __builtin_amdgcn_s_sleep(1);
        if ((++sp & 255u) == 0u) { if (xb_ld(&bar[XB_TMO])) break; if (sp > XB_SPIN_CAP) { atomicAdd(&bar[XB_TMO], 1u); break; } }
    }
    nloc = mine > 0u ? mine : 1u; nx = cnt > 0u ? cnt : 1u;
}
__device__ __forceinline__ void xcd_barrier(const XcdBarrier& b) {
    asm volatile("s_waitcnt vmcnt(0)" ::: "memory");
    __syncthreads();
    if (threadIdx.x == 0) {
        unsigned* bar = b.bar;
        __builtin_amdgcn_s_waitcnt(0);
        unsigned nloc = b.st[0], nx = b.st[1];
        if (nloc == 0u) { xcd_barrier_complete(bar, b.x, nloc, nx); b.st[0] = nloc; b.st[1] = nx; }
        const unsigned old = xb_add(&bar[XB_XSUB(b.x)], 1u);
        const unsigned gen = old / nloc;
        if (old + 1u == (gen + 1u) * nloc) {
            __builtin_amdgcn_fence(__ATOMIC_RELEASE, "agent");
            asm volatile("s_waitcnt vmcnt(0)" ::: "memory");
            const unsigned og = xb_add(&bar[XB_TOP], 1u);
            const unsigned tg = og / nx;
            if (og + 1u == (tg + 1u) * nx) xb_add(&bar[XB_TOPGEN], 1u);
            else XB_SPIN(xb_ld(&bar[XB_TOPGEN]) == tg, bar);
            __builtin_amdgcn_fence(__ATOMIC_ACQUIRE, "agent");
            xb_add(&bar[XB_XGEN(b.x)], 1u);
            asm volatile("s_waitcnt vmcnt(0)" ::: "memory");
        } else {
            XB_SPIN(xb_ld(&bar[XB_XGEN(b.x)]) == gen, bar);
            __builtin_amdgcn_fence(__ATOMIC_ACQUIRE, "agent");
            asm volatile("s_waitcnt vmcnt(0)" ::: "memory");
        }
    }
    __syncthreads();
}

__global__ void __launch_bounds__(512) fwd_kernel(Params p) {
    extern __shared__ __attribute__((aligned(16))) unsigned char smem[];
    cg::grid_group grid = cg::this_grid();
    __shared__ __attribute__((aligned(16))) unsigned xb_words[4];
    if (threadIdx.x < 4) xb_words[threadIdx.x] = 0u;
    __syncthreads();
    const XcdBarrier xb = xcd_barrier_post((unsigned*)(p.ws + WS_CTL) + 256, (volatile LAS unsigned*)xb_words);
    int ph = 0;
#define PHASE(...) { if (ph >= p.ph_lo && ph < p.ph_hi) { __VA_ARGS__; if (ph + 1 < p.ph_hi) { if (p.ph_lo < 0) grid.sync(); else xcd_barrier(xb); } } ++ph; }
    PHASE(phase_prologue(p, smem));
    float* xc = (float*)(p.ws + WS_XC);
    bf16_t* HB = (bf16_t*)(p.ws + WS_HB);
    bf16_t* PA = (bf16_t*)(p.ws + WS_PA);
#pragma unroll 1
    for (int l = 0; l < DEPTH; ++l) {
        const float* modl = (const float*)(p.ws + WS_MODS) + (size_t)l * 9 * NMODC;
        const float* xlat = (l == 0) ? p.x : p.out;
        float* xctx = xc;
        const int mrows = (l < DEPTH - 1) ? MTOT : NLAT;
        PHASE({ norm_rows(xlat, xctx, MTOT, p.norm1_g + l * D, modl, 0, D, HB, (const float*)(p.ws + WS_HFB), (l > 0) ? 8 : 0); convert_weights(p, l, smem); });
        PHASE({ EpiInProj e{PA, (float*)(p.ws + WS_GATES), (const float*)(p.ws + WS_ROPE), (const float*)(p.ws + WS_ROPE) + SEQ * 32};
                gemm_phase(HB, (const bf16_t*)(p.ws + WS_WIN), MTOT, DINP, D, e, smem); });
        PHASE(phase_mixers(p, l, smem));
        PHASE(phase_mfinal(p, l));
        PHASE({ EpiResid e{xlat, p.out, xctx, xc, modl + 2 * D, (float*)(p.ws + WS_HFB)};
                gemm_phase(HB, (const bf16_t*)(p.ws + WS_WOUT), mrows, D, D, e, smem, (mrows > NLAT) ? 4 : 1); });
        PHASE(norm_rows(p.out, xc, mrows, p.norm2_g + l * D, modl, 3 * D, 4 * D, HB, (const float*)(p.ws + WS_HFB), 4));
        PHASE({ EpiRelu2 e{PA};
                gemm_phase(HB, (const bf16_t*)(p.ws + WS_W1), mrows, DFF, D, e, smem); });
        PHASE({ EpiResid e{p.out, p.out, xc, xc, modl + 5 * D, (float*)(p.ws + WS_HFB)};
                gemm_phase(PA, (const bf16_t*)(p.ws + WS_W2), mrows, D, DFF, e, smem, (mrows > NLAT) ? 8 : 1); });
    }
    PHASE(phase_final(p));
#undef PHASE
}

constexpr int N_PHASES = 2 + 8 * DEPTH;

extern "C" void kernel_launch(void* const* d_in, const int* in_sizes, int n_in, void* d_out, int out_size, void* d_ws, size_t ws_size, hipStream_t stream) {
    static int grid_blocks = 0;
    if (grid_blocks == 0) {
        if (n_in != 16 || out_size != NLAT * D || ws_size < WS_END) { fprintf(stderr, "kernel_launch: unexpected shapes (n_in %d out %d ws %zu need %zu)\n", n_in, out_size, ws_size, (size_t)WS_END); grid_blocks = -1; return; }
        int dev = 0, cus = 0, per_cu = 0;
        (void)hipGetDevice(&dev);
        (void)hipDeviceGetAttribute(&cus, hipDeviceAttributeMultiprocessorCount, dev);
        (void)hipFuncSetAttribute((const void*)fwd_kernel, hipFuncAttributeMaxDynamicSharedMemorySize, SHM_BYTES);
        (void)hipOccupancyMaxActiveBlocksPerMultiprocessor(&per_cu, (const void*)fwd_kernel, NTHR, SHM_BYTES);
        if (per_cu < 1) per_cu = 1;
        if (per_cu > 1) per_cu = 1;
        grid_blocks = cus * per_cu;
    }
    if (grid_blocks < 0) return;
    (void)hipMemsetAsync((char*)d_ws + WS_CTL, 0, 16384, stream);
    Params p{};
    p.x = (const float*)d_in[0]; p.c = (const float*)d_in[1]; p.ctx = (const float*)d_in[2]; p.c_ctx = (const float*)d_in[3];
    p.w_ada = (const float*)d_in[4]; p.b_ada = (const float*)d_in[5]; p.norm1_g = (const float*)d_in[6]; p.w_in = (const float*)d_in[7];
    p.b_gate = (const float*)d_in[8]; p.mlstm_norm_g = (const float*)d_in[9]; p.rpb = (const float*)d_in[10]; p.w_out = (const float*)d_in[11];
    p.norm2_g = (const float*)d_in[12]; p.w_mlp1 = (const float*)d_in[13]; p.w_mlp2 = (const float*)d_in[14]; p.final_g = (const float*)d_in[15];
    p.out = (float*)d_out; p.ws = (unsigned char*)d_ws;
#if defined(MULTI_LAUNCH)
    for (int ph = 0; ph < N_PHASES; ++ph) {
        p.ph_lo = ph; p.ph_hi = ph + 1;
        hipLaunchKernelGGL(fwd_kernel, dim3(grid_blocks), dim3(NTHR), SHM_BYTES, stream, p);
    }
#else
    p.ph_lo = 0; p.ph_hi = N_PHASES;
    void* args[] = {&p};
    hipError_t e = hipLaunchCooperativeKernel((const void*)fwd_kernel, dim3(grid_blocks), dim3(NTHR), args, SHM_BYTES, stream);
    if (e != hipSuccess) fprintf(stderr, "cooperative launch failed: %s (grid %d)\n", hipGetErrorString(e), grid_blocks);
#endif
}
```

```cpp
#include <hip/hip_runtime.h>
#include <hip/hip_cooperative_groups.h>
#include <cstdio>
#include <cstdint>
namespace cg = cooperative_groups;

typedef unsigned short bf16_t;
typedef short bf16x8 __attribute__((ext_vector_type(8)));
typedef float f32x4 __attribute__((ext_vector_type(4)));
typedef unsigned u32x4 __attribute__((ext_vector_type(4)));
typedef unsigned u32x2 __attribute__((ext_vector_type(2)));

constexpr int D = 1024, NB = 8, SEQ = 4096, DEPTH = 4, CTXL = 256;
constexpr int DIN = 3616, DINP = 3840, PW = 3584, DFF = 4096;
constexpr int NLAT = NB * SEQ, NCTX = NB * CTXL, MTOT = NLAT + NCTX;
constexpr int NMODC = 6 * D;
constexpr int LDSS = 72;
constexpr int NTHR = 512, NWAVE = 8;
constexpr int SHM_BYTES = 131072;

constexpr size_t WS_CTL = 0;
constexpr size_t WS_MODS = 16384;
constexpr size_t WS_ROPE = WS_MODS + (size_t)DEPTH * 9 * NMODC * 4;
constexpr size_t WS_GATES = WS_ROPE + (size_t)2 * SEQ * 32 * 4;
constexpr size_t WS_XC = WS_GATES + (size_t)MTOT * 32 * 4;
constexpr size_t WS_WIN = WS_XC + (size_t)NCTX * D * 4;
constexpr size_t WS_WOUT = WS_WIN + (size_t)DINP * D * 2;
constexpr size_t WS_W1 = WS_WOUT + (size_t)D * D * 2;
constexpr size_t WS_W2 = WS_W1 + (size_t)DFF * D * 2;
constexpr size_t WS_HB = WS_W2 + (size_t)DFF * D * 2;
constexpr size_t WS_HFB = WS_HB + (size_t)MTOT * D * 2;
constexpr size_t WS_PA = WS_HFB + (size_t)2 * MTOT * 512 * 2;
constexpr size_t WS_XB = WS_PA + (size_t)MTOT * DFF * 2;
constexpr size_t WS_END = WS_XB + (size_t)NLAT * D * 2;
static_assert(WS_END <= (size_t)512 * 1024 * 1024, "workspace");
static_assert(WS_ROPE % 256 == 0 && WS_GATES % 256 == 0 && WS_XC % 256 == 0 && WS_WIN % 256 == 0 && WS_HB % 256 == 0 && WS_HFB % 256 == 0 && WS_PA % 256 == 0, "align");

constexpr int TPB = SEQ + CTXL;
constexpr size_t HM_T = (size_t)NB * 8 * TPB * 64;
constexpr size_t OG_OFF = 6 * HM_T;
static_assert(OG_OFF + (size_t)MTOT * 512 == (size_t)MTOT * PW, "layout");
__device__ __forceinline__ size_t hm_off(int ten, int b, int h, int tt) { return (size_t)ten * HM_T + ((size_t)(b * 8 + h) * TPB + tt) * 64; }

struct Params {
    const float *x, *c, *ctx, *c_ctx, *w_ada, *b_ada, *norm1_g, *w_in, *b_gate, *mlstm_norm_g, *rpb, *w_out, *norm2_g, *w_mlp1, *w_mlp2, *final_g;
    float* out;
    unsigned char* ws;
    int ph_lo, ph_hi;
};

__device__ __forceinline__ unsigned pk2(float lo, float hi) { unsigned r; asm("v_cvt_pk_bf16_f32 %0, %1, %2" : "=v"(r) : "v"(lo), "v"(hi)); return r; }
__device__ __forceinline__ bf16_t f2bf(float f) { return (bf16_t)(pk2(f, 0.f) & 0xffffu); }
__device__ __forceinline__ float bf2f(unsigned v) { return __uint_as_float(v << 16); }
__device__ __forceinline__ float bflo(unsigned w) { return __uint_as_float(w << 16); }
__device__ __forceinline__ float bfhi(unsigned w) { return __uint_as_float(w & 0xffff0000u); }
__device__ __forceinline__ float wave_sum(float v) {
#pragma unroll
    for (int o = 1; o < 64; o <<= 1) v += __shfl_xor(v, o);
    return v;
}
__device__ __forceinline__ int otid() { int t = threadIdx.x; asm volatile("" : "+v"(t)); return t; }
__device__ __forceinline__ f32x4 mfma16(bf16x8 a, bf16x8 b, f32x4 c) { return __builtin_amdgcn_mfma_f32_16x16x32_bf16(a, b, c, 0, 0, 0); }
__device__ __forceinline__ bf16x8 as_bf16x8(u32x4 v) { return __builtin_bit_cast(bf16x8, v); }

__device__ void phase_prologue(const Params& p, unsigned char* smem) {
    float* sl = (float*)smem;
    float* red = sl + 9 * 1024;
    const int tid = otid();
    {
        float* cosT = (float*)(p.ws + WS_ROPE);
        float* sinT = cosT + SEQ * 32;
        for (int i = blockIdx.x * NTHR + tid; i < SEQ * 32; i += gridDim.x * NTHR) {
            const int t = i >> 5, dp = i & 31;
            const float pos = (dp < 16) ? (float)(t >> 6) : (float)(t & 63);
            const float inv = exp2f(-(float)(dp & 15) * (13.287712379549449f / 16.f));
            const float ang = pos * inv;
            cosT[i] = __cosf(ang);
            sinT[i] = __sinf(ang);
        }
    }
    {
        const f32x4* src = (const f32x4*)p.ctx; f32x4* dst = (f32x4*)(p.ws + WS_XC);
        for (int i = blockIdx.x * NTHR + tid; i < NCTX * D / 4; i += gridDim.x * NTHR) dst[i] = src[i];
    }
    if (blockIdx.x >= DEPTH * 96) return;
    for (int i = tid; i < 9 * 1024; i += NTHR) {
        const int r = i >> 10, k = i & 1023;
        const float v = (r < 8) ? p.c[r * 1024 + k] : p.c_ctx[k];
        sl[i] = v / (1.f + __expf(-v));
    }
    __syncthreads();
    float* mods = (float*)(p.ws + WS_MODS);
    for (int item = blockIdx.x; item < DEPTH * 96; item += gridDim.x) {
        const int l = item / 96, cb = item % 96, cl = tid & 63, kg = tid >> 6;
        const float* w = p.w_ada + (size_t)l * D * NMODC + cb * 64 + cl;
        float acc[9];
#pragma unroll
        for (int r = 0; r < 9; ++r) acc[r] = 0.f;
#pragma unroll 32
        for (int k = kg * 128; k < kg * 128 + 128; ++k) {
            const float wv = w[(size_t)k * NMODC];
#pragma unroll
            for (int r = 0; r < 9; ++r) acc[r] += sl[r * 1024 + k] * wv;
        }
#pragma unroll
        for (int r = 0; r < 9; ++r) red[(kg * 9 + r) * 64 + cl] = acc[r];
        __syncthreads();
        for (int i = tid; i < 9 * 64; i += NTHR) {
            const int r = i >> 6, c2 = i & 63;
            float s = 0.f;
#pragma unroll
            for (int g8 = 0; g8 < 8; ++g8) s += red[(g8 * 9 + r) * 64 + c2];
            mods[(size_t)(l * 9 + r) * NMODC + cb * 64 + c2] = s + p.b_ada[l * NMODC + cb * 64 + c2];
        }
        __syncthreads();
    }
}

__device__ __forceinline__ void norm_store_row(const f32x4 (&v)[4], int row, int b, int lane, const float* g, const float* modl, int sh_off, int sc_off, bf16_t* outp) {
    float s = 0.f;
#pragma unroll
    for (int j = 0; j < 4; ++j) s += (v[j].x * v[j].x + v[j].y * v[j].y) + (v[j].z * v[j].z + v[j].w * v[j].w);
    s = wave_sum(s);
    const float rstd = 1.0f / sqrtf(s * (1.f / D) + 1e-6f);
    const float* sh = modl + b * NMODC + sh_off;
    const float* sc = modl + b * NMODC + sc_off;
#pragma unroll
    for (int j = 0; j < 4; ++j) {
        const int col = (lane + 64 * j) * 4;
        const f32x4 gv = *(const f32x4*)(g + col), scv = *(const f32x4*)(sc + col), shv = *(const f32x4*)(sh + col);
        const f32x4 o = (v[j] * rstd * gv) * (1.f + scv) + shv;
        u32x2 wv; wv.x = pk2(o.x, o.y); wv.y = pk2(o.z, o.w);
        *(u32x2*)(outp + (size_t)row * D + col) = wv;
    }
}
__device__ void norm_rows(const float* xlat32, const bf16_t* xlat16, float* xctx, int nrows, const float* g, const float* modl, int sh_off, int sc_off, bf16_t* outp, const float* part, int npart) {
    const int tid = otid(), lane = tid & 63;
    const int nw = gridDim.x * NWAVE, w0 = blockIdx.x * NWAVE + (tid >> 6);
    for (int row = w0; row < NLAT; row += 4 * nw) {
        f32x4 v[4][4];
        if (xlat32) {
#pragma unroll
            for (int i = 0; i < 4; ++i) {
                const int r = min(row + i * nw, NLAT - 1);
#pragma unroll
                for (int j = 0; j < 4; ++j) v[i][j] = ((const f32x4*)(xlat32 + (size_t)r * D))[lane + 64 * j];
            }
        } else {
            u32x2 q[4][4];
#pragma unroll
            for (int i = 0; i < 4; ++i) {
                const int r = min(row + i * nw, NLAT - 1);
#pragma unroll
                for (int j = 0; j < 4; ++j) q[i][j] = ((const u32x2*)(xlat16 + (size_t)r * D))[lane + 64 * j];
            }
#pragma unroll
            for (int i = 0; i < 4; ++i)
#pragma unroll
                for (int j = 0; j < 4; ++j) v[i][j] = (f32x4){bflo(q[i][j].x), bfhi(q[i][j].x), bflo(q[i][j].y), bfhi(q[i][j].y)};
        }
#pragma unroll
        for (int i = 0; i < 4; ++i) {
            const int r = row + i * nw;
            if (r < NLAT) norm_store_row(v[i], r, r >> 12, lane, g, modl, sh_off, sc_off, outp);
        }
    }
    for (int row = NLAT + w0; row < nrows; row += nw) {
        const float* xr = xctx + (size_t)(row - NLAT) * D;
        f32x4 v[4];
#pragma unroll
        for (int j = 0; j < 4; ++j) v[j] = ((const f32x4*)xr)[lane + 64 * j];
        if (npart > 0) {
            for (int sl = 0; sl < npart; ++sl) {
                const f32x4* pr = (const f32x4*)(part + (size_t)sl * NCTX * D + (size_t)(row - NLAT) * D);
#pragma unroll
                for (int j = 0; j < 4; ++j) v[j] += pr[lane + 64 * j];
            }
#pragma unroll
            for (int j = 0; j < 4; ++j) ((f32x4*)(xctx + (size_t)(row - NLAT) * D))[lane + 64 * j] = v[j];
        }
        norm_store_row(v, row, 8, lane, g, modl, sh_off, sc_off, outp);
    }
}

__device__ __forceinline__ int rope_perm(int n) { return ((n >> 5) & 1) * 16 + (n & 15) + 32 * ((n >> 4) & 1); }
__device__ __forceinline__ void transpose_item(const float* W, int K, int N, bf16_t* WT, int kt, int nt, float* tile, int nperm) {
    const int tid = otid(), k0 = kt * 64, n0 = nt * 64;
    {
        const int r = tid >> 4, c4 = (tid & 15) * 4;
#pragma unroll
        for (int ps = 0; ps < 2; ++ps) {
            const int k = ps * 32 + r;
            f32x4 v = {0.f, 0.f, 0.f, 0.f};
            int lc = n0 + c4;
            if (nperm == -2) { const int p0 = (n0 & 255) + (c4 & 32); lc = (n0 & ~255) + ((p0 >> 5) & 3) * 64 + (p0 >> 7) * 32 + (c4 & 31); }
            if (lc < N) v = *(const f32x4*)(W + (size_t)(k0 + k) * N + lc);
            tile[k * 65 + c4 + 0] = v.x; tile[k * 65 + c4 + 1] = v.y; tile[k * 65 + c4 + 2] = v.z; tile[k * 65 + c4 + 3] = v.w;
        }
    }
    __syncthreads();
    {
        const int kg = tid & 7, n = tid >> 3;
        const int nl = (nperm < 0) ? ((n & 32) + 8 * ((n & 15) >> 2) + 4 * ((n >> 4) & 1) + (n & 3)) : n;
        const float* s = tile + (kg * 8) * 65 + nl;
        u32x4 o; o.x = pk2(s[0], s[65]); o.y = pk2(s[2 * 65], s[3 * 65]); o.z = pk2(s[4 * 65], s[5 * 65]); o.w = pk2(s[6 * 65], s[7 * 65]);
        *(u32x4*)(WT + (size_t)(n0 + n) * K + k0 + kg * 8) = o;
    }
    __syncthreads();
}
__device__ void convert_weights(const Params& p, int l, unsigned char* smem) {
    float* tile = (float*)smem;
    constexpr int I_IN = 16 * (DINP / 64), I_OUT = 16 * 16, I_1 = 16 * 64, I_2 = 64 * 16;
    for (int it = blockIdx.x; it < I_IN + I_OUT + I_1 + I_2; it += gridDim.x) {
        int r = it;
        if (r < I_IN) { const int n0i = (r / 16) * 64; transpose_item(p.w_in + (size_t)l * D * DIN, D, DIN, (bf16_t*)(p.ws + WS_WIN), r % 16, r / 16, tile, n0i < 1024 ? -2 : (n0i < PW ? -1 : 0)); continue; }
        r -= I_IN;
        if (r < I_OUT) { transpose_item(p.w_out + (size_t)l * D * D, D, D, (bf16_t*)(p.ws + WS_WOUT), r % 16, r / 16, tile, -1); continue; }
        r -= I_OUT;
        if (r < I_1) { transpose_item(p.w_mlp1 + (size_t)l * D * DFF, D, DFF, (bf16_t*)(p.ws + WS_W1), r % 16, r / 16, tile, -1); continue; }
        r -= I_1;
        transpose_item(p.w_mlp2 + (size_t)l * DFF * D, DFF, D, (bf16_t*)(p.ws + WS_W2), r % 64, r / 64, tile, -1);
    }
}

constexpr int G_BM = 256, G_BK = 64, G_HALF = 128, G_HT = G_HALF * G_BK;
__device__ __forceinline__ int lds_byte(int r, int c) { const int st = (r >> 4) * 2 + (c >> 5), rr = r & 15, cc = c & 31, ob = rr * 64 + cc * 2; return st * 1024 + (ob ^ (((ob >> 9) & 1) << 5)); }
__device__ __forceinline__ void stage_rc(int b, int& R, int& C) { const int st = b / 1024, sb = b % 1024, swz = sb ^ (((sb >> 9) & 1) << 5); R = (st >> 1) * 16 + swz / 64; C = (st & 1) * 32 + (swz % 64) / 2; }
#define LAS __attribute__((address_space(3)))
template <class Epi>
__device__ __forceinline__ void gemm_phase(const bf16_t* __restrict__ A, const bf16_t* __restrict__ Bt, int M, int N, int K, const Epi& epi, unsigned char* smem, int S = 1) {
    LAS unsigned char* lds = (LAS unsigned char*)smem;
    const int tid = otid(), wid = __builtin_amdgcn_readfirstlane(tid >> 6), lane = tid & 63, wr = wid >> 2, wc = wid & 3, fr = lane & 15, fq = lane >> 4;
    unsigned voff[2];
#pragma unroll
    for (int i = 0; i < 2; ++i) { int R, C; stage_rc(tid * 16 + i * 8192, R, C); voff[i] = (unsigned)(R * K + C) * 2u; }
    const size_t hstep = (size_t)G_HALF * K * 2;
    const unsigned ldsw = (unsigned)wid * 1024u;
    const int aoff = lds_byte(wr * 64 + fr, fq * 8), boff = lds_byte(wc * 32 + fr, fq * 8);
#define SA(b, h) (((b) * 2 + (h)) * 16384)
#define SB(b, h) ((4 + (b) * 2 + (h)) * 16384)
#define STAGE(bufoff, gbase) do { _Pragma("unroll") for (int _i = 0; _i < 2; ++_i) \
      __builtin_amdgcn_global_load_lds((const unsigned*)((const char*)(gbase) + voff[_i]), (LAS unsigned*)(lds + (bufoff) + ldsw + _i * 8192), 16, 0, 0); } while (0)
#define LDA(dst, b, h) do { _Pragma("unroll") for (int m = 0; m < 4; ++m) _Pragma("unroll") for (int k = 0; k < 2; ++k) dst[m][k] = *(const LAS bf16x8*)(lds + SA(b, h) + aoff + m * 2048 + k * 1024); } while (0)
#define LDB(dst, b, h) do { _Pragma("unroll") for (int n = 0; n < 2; ++n) _Pragma("unroll") for (int k = 0; k < 2; ++k) dst[n][k] = *(const LAS bf16x8*)(lds + SB(b, h) + boff + n * 2048 + k * 1024); } while (0)
#define MMA(ai, bj, At_, Bt_) do { __builtin_amdgcn_s_setprio(1); \
    _Pragma("unroll") for (int m = 0; m < 4; ++m) _Pragma("unroll") for (int n = 0; n < 2; ++n) _Pragma("unroll") for (int k = 0; k < 2; ++k) \
      acc[ai][bj][m][n] = __builtin_amdgcn_mfma_f32_16x16x32_bf16(Bt_[n][k], At_[m][k], acc[ai][bj][m][n], 0, 0, 0); \
    __builtin_amdgcn_s_setprio(0); } while (0)
#define WAIT_V(n) asm volatile("s_waitcnt vmcnt(" #n ")" ::: "memory")
#define WAIT_L(n) asm volatile("s_waitcnt lgkmcnt(" #n ")" ::: "memory")
#define BAR __builtin_amdgcn_s_barrier()
#define SCHED __builtin_amdgcn_sched_barrier(0)
    const int nM = M / G_BM, nN = N / G_BM, nMf = (S > 1) ? (NLAT / G_BM) : nM, nwg = nMf * nN, nsp = (nM - nMf) * nN * S, ksl = K / S;
    auto unit = [&](int round, int& brow, int& bcol, int& k0) __attribute__((always_inline)) -> bool {
        int wgid = round * (int)gridDim.x + (int)blockIdx.x;
        if (wgid >= nwg + nsp) return false;
        if (wgid >= nwg) { const int r = wgid - nwg, tl = r / S; k0 = (r - tl * S) * ksl; brow = (nMf + tl % (nM - nMf)) * G_BM; bcol = (tl / (nM - nMf)) * G_BM; return true; }
        { const int q = nwg / 8, r = nwg % 8, xcd = wgid % 8, off = wgid / 8; wgid = (xcd < r ? xcd * (q + 1) : r * (q + 1) + (xcd - r) * q) + off; }
        const int nig = 8 * nN, gid = wgid / nig, fm = gid * 8, gsz = min(nMf - fm, 8);
        brow = (fm + ((wgid % nig) % gsz)) * G_BM; bcol = ((wgid % nig) / gsz) * G_BM; k0 = 0;
        return true;
    };
    int ui = 0, brow, bcol, k0;
    if (!unit(0, brow, bcol, k0)) return;
    const char* cA = (const char*)A + ((size_t)brow * K + k0) * 2;
    const char* cB = (const char*)Bt + ((size_t)bcol * K + k0) * 2;
    f32x4 acc[2][2][4][2];
#pragma unroll
    for (int a0 = 0; a0 < 2; ++a0)
#pragma unroll
        for (int a1 = 0; a1 < 2; ++a1)
#pragma unroll
            for (int a2 = 0; a2 < 4; ++a2)
#pragma unroll
                for (int a3 = 0; a3 < 2; ++a3) acc[a0][a1][a2][a3] = (f32x4){0.f, 0.f, 0.f, 0.f};
    bf16x8 At[4][2], B0[2][2], B1[2][2];
    STAGE(SB(0, 0), cB); STAGE(SB(0, 1), cB + hstep); STAGE(SA(0, 0), cA); STAGE(SA(0, 1), cA + hstep);
    if (wr == 1) BAR;
    WAIT_V(2); BAR;
    STAGE(SB(1, 0), cB + 128); STAGE(SA(1, 0), cA + 128); STAGE(SB(1, 1), cB + hstep + 128);
    WAIT_V(6); BAR;
#pragma unroll 1
    for (;;) {
        int nbrow = 0, nbcol = 0, nk0 = 0;
        const bool has_next = unit(ui + 1, nbrow, nbcol, nk0);
        const bool split = brow >= nMf * G_BM;
        const int nt = (split ? ksl : K) / G_BK;
        const char* nA = has_next ? (const char*)A + ((size_t)nbrow * K + nk0) * 2 : cA;
        const char* nB = has_next ? (const char*)Bt + ((size_t)nbcol * K + nk0) * 2 : cB;
#pragma unroll 1
        for (int t = 0; t < nt; t += 2) {
            const bool last = (t == nt - 2);
            const char* a1 = cA + (size_t)(t + 1) * 128;
            const char* a2 = last ? nA : cA + (size_t)(t + 2) * 128; const char* b2 = last ? nB : cB + (size_t)(t + 2) * 128;
            const char* a3 = a2 + 128; const char* b3 = b2 + 128;
            LDB(B0, 0, 0); LDB(B1, 0, 1); SCHED; LDA(At, 0, 0); STAGE(SA(1, 1), a1 + hstep);
            WAIT_V(8); WAIT_L(0); BAR; MMA(0, 0, At, B0); MMA(0, 1, At, B1); BAR; SCHED;
            LDA(At, 0, 1); STAGE(SB(0, 0), b2); STAGE(SB(0, 1), b2 + hstep); STAGE(SA(0, 0), a2);
            WAIT_V(8); WAIT_L(0); BAR; MMA(1, 0, At, B0); MMA(1, 1, At, B1); BAR; SCHED;
            LDB(B0, 1, 0); LDB(B1, 1, 1); SCHED; LDA(At, 1, 0); STAGE(SA(0, 1), a2 + hstep);
            WAIT_V(8); WAIT_L(0); BAR; MMA(0, 0, At, B0); MMA(0, 1, At, B1); BAR; SCHED;
            LDA(At, 1, 1); STAGE(SB(1, 0), b3); STAGE(SB(1, 1), b3 + hstep); STAGE(SA(1, 0), a3);
            WAIT_V(8); WAIT_L(0); BAR; MMA(1, 0, At, B0); MMA(1, 1, At, B1); BAR; SCHED;
        }
        if (wr == 0) BAR;
        epi(acc, brow + wr * 64 + fr, bcol + wc * 32 + fq * 4, wc, fq, split ? k0 / ksl : -1);
        if (!has_next) break;
#pragma unroll
        for (int a0 = 0; a0 < 2; ++a0)
#pragma unroll
            for (int a1 = 0; a1 < 2; ++a1)
#pragma unroll
                for (int a2 = 0; a2 < 4; ++a2)
#pragma unroll
                    for (int a3 = 0; a3 < 2; ++a3) acc[a0][a1][a2][a3] = (f32x4){0.f, 0.f, 0.f, 0.f};
        cA = nA; cB = nB; brow = nbrow; bcol = nbcol; k0 = nk0; ++ui;
        if (wr == 1) BAR;
    }
    WAIT_V(0);
    BAR;
#undef SA
#undef SB
#undef STAGE
#undef LDA
#undef LDB
#undef MMA
#undef WAIT_V
#undef WAIT_L
#undef BAR
#undef SCHED
}

struct EpiInProj {
    bf16_t* P; float* gates; const float* cosT; const float* sinT;
    __device__ __forceinline__ void operator()(f32x4 (&acc)[2][2][4][2], int row0, int col0, int wc, int fq, int slice) const {
        if (col0 >= PW) {
            if (wc == 0) {
#pragma unroll
                for (int ai = 0; ai < 2; ++ai)
#pragma unroll
                    for (int m = 0; m < 4; ++m) {
                        const int row = row0 + ai * 128 + m * 16;
#pragma unroll
                        for (int n = 0; n < 2; ++n) *(f32x4*)(gates + (size_t)row * 32 + n * 16 + fq * 4) = acc[ai][0][m][n];
                    }
            }
            return;
        }
        const bool lat = row0 < NLAT;
        const int bb = lat ? (row0 >> 12) : ((row0 - NLAT) >> 8);
        const int tt0 = lat ? (row0 & (SEQ - 1)) : (SEQ + ((row0 - NLAT) & (CTXL - 1)));
        const int tb = col0 - wc * 32 - fq * 4;
        if (col0 < 1024) {
            const float scale = (col0 < 512) ? 0.125f : 1.f;
            const int c = tb + wc * 64;
            bf16_t* base = P + hm_off(c >> 9, bb, (c & 511) >> 6, tt0) + 8 * fq;
#pragma unroll
            for (int ai = 0; ai < 2; ++ai)
#pragma unroll
                for (int m = 0; m < 4; ++m) {
                    const int dr = ai * 128 + m * 16;
                    f32x4 x1[2], x2[2];
#pragma unroll
                    for (int n = 0; n < 2; ++n) {
                        x1[n] = acc[ai][0][m][n]; x2[n] = acc[ai][1][m][n];
                        if (lat) {
                            const int t = tt0 + dr;
                            const f32x4 c4 = *(const f32x4*)(cosT + t * 32 + 8 * fq + 4 * n), s4 = *(const f32x4*)(sinT + t * 32 + 8 * fq + 4 * n);
                            const f32x4 y1 = x1[n] * c4 - x2[n] * s4, y2 = x1[n] * s4 + x2[n] * c4;
                            x1[n] = y1; x2[n] = y2;
                        }
                        x1[n] = x1[n] * scale; x2[n] = x2[n] * scale;
                    }
                    u32x4 w1; w1.x = pk2(x1[0].x, x1[0].y); w1.y = pk2(x1[0].z, x1[0].w); w1.z = pk2(x1[1].x, x1[1].y); w1.w = pk2(x1[1].z, x1[1].w);
                    u32x4 w2; w2.x = pk2(x2[0].x, x2[0].y); w2.y = pk2(x2[0].z, x2[0].w); w2.z = pk2(x2[1].x, x2[1].y); w2.w = pk2(x2[1].z, x2[1].w);
                    *(u32x4*)(base + (size_t)dr * 64) = w1;
                    *(u32x4*)(base + (size_t)dr * 64 + 32) = w2;
                }
            return;
        }
        const int colp = col0 + 4 * fq;
        if (col0 >= 1536 && col0 < 2048) {
#pragma unroll
            for (int ai = 0; ai < 2; ++ai)
#pragma unroll
                for (int m = 0; m < 4; ++m) {
                    const int row = row0 + ai * 128 + m * 16;
#pragma unroll
                    for (int bj = 0; bj < 2; ++bj) {
                        const f32x4 v0 = acc[ai][bj][m][0], v1 = acc[ai][bj][m][1];
                        u32x4 wv; wv.x = pk2(v0.x, v0.y); wv.y = pk2(v0.z, v0.w); wv.z = pk2(v1.x, v1.y); wv.w = pk2(v1.z, v1.w);
                        *(u32x4*)(P + OG_OFF + (size_t)row * 512 + (colp - 1536) + bj * 128) = wv;
                    }
                }
            return;
        }
        const float scale = (col0 >= 2048 && col0 < 2560) ? 0.125f : 1.f;
        const int ten = (col0 < 1536) ? 2 : (3 + ((col0 - 2048) >> 9));
#pragma unroll
        for (int bj = 0; bj < 2; ++bj) {
            const int c = colp + bj * 128;
            bf16_t* base = P + hm_off(ten, bb, (c & 511) >> 6, tt0) + (c & 63);
#pragma unroll
            for (int ai = 0; ai < 2; ++ai)
#pragma unroll
                for (int m = 0; m < 4; ++m) {
                    const f32x4 v0 = acc[ai][bj][m][0] * scale, v1 = acc[ai][bj][m][1] * scale;
                    u32x4 wv; wv.x = pk2(v0.x, v0.y); wv.y = pk2(v0.z, v0.w); wv.z = pk2(v1.x, v1.y); wv.w = pk2(v1.z, v1.w);
                    *(u32x4*)(base + (size_t)(ai * 128 + m * 16) * 64) = wv;
                }
        }
    }
};
struct EpiResid {
    const float* xin32; const bf16_t* xin16; bf16_t* xout; const float* g; float* part;
    __device__ __forceinline__ void operator()(f32x4 (&acc)[2][2][4][2], int row0, int col0, int wc, int fq, int slice) const {
        const int colp = col0 + 4 * fq;
        const int b = (row0 < NLAT) ? (row0 >> 12) : 8;
        const float* gb = g + b * NMODC + colp;
        f32x4 gv[2][2];
#pragma unroll
        for (int bj = 0; bj < 2; ++bj)
#pragma unroll
            for (int n = 0; n < 2; ++n) gv[bj][n] = *(const f32x4*)(gb + bj * 128 + n * 4);
        if (slice >= 0) {
            float* pb = part + (size_t)slice * NCTX * D + (size_t)(row0 - NLAT) * D + colp;
#pragma unroll
            for (int ai = 0; ai < 2; ++ai)
#pragma unroll
                for (int m = 0; m < 4; ++m)
#pragma unroll
                    for (int bj = 0; bj < 2; ++bj)
#pragma unroll
                        for (int n = 0; n < 2; ++n) *(f32x4*)(pb + (size_t)(ai * 128 + m * 16) * D + bj * 128 + n * 4) = gv[bj][n] * acc[ai][bj][m][n];
            return;
        }
        bf16_t* dst = xout + (size_t)row0 * D + colp;
        if (xin32) {
            const float* src = xin32 + (size_t)row0 * D + colp;
#pragma unroll
            for (int ai = 0; ai < 2; ++ai) {
                f32x4 xv[4][2][2];
#pragma unroll
                for (int m = 0; m < 4; ++m)
#pragma unroll
                    for (int bj = 0; bj < 2; ++bj)
#pragma unroll
                        for (int n = 0; n < 2; ++n) xv[m][bj][n] = *(const f32x4*)(src + (size_t)(ai * 128 + m * 16) * D + bj * 128 + n * 4);
#pragma unroll
                for (int m = 0; m < 4; ++m)
#pragma unroll
                    for (int bj = 0; bj < 2; ++bj) {
                        const f32x4 o0 = xv[m][bj][0] + gv[bj][0] * acc[ai][bj][m][0], o1 = xv[m][bj][1] + gv[bj][1] * acc[ai][bj][m][1];
                        u32x4 wv; wv.x = pk2(o0.x, o0.y); wv.y = pk2(o0.z, o0.w); wv.z = pk2(o1.x, o1.y); wv.w = pk2(o1.z, o1.w);
                        *(u32x4*)(dst + (size_t)(ai * 128 + m * 16) * D + bj * 128) = wv;
                    }
                asm volatile("" ::: "memory");
            }
        } else {
            const bf16_t* src = xin16 + (size_t)row0 * D + colp;
#pragma unroll
            for (int ai = 0; ai < 2; ++ai) {
                u32x4 xv[4][2];
#pragma unroll
                for (int m = 0; m < 4; ++m)
#pragma unroll
                    for (int bj = 0; bj < 2; ++bj) xv[m][bj] = *(const u32x4*)(src + (size_t)(ai * 128 + m * 16) * D + bj * 128);
#pragma unroll
                for (int m = 0; m < 4; ++m)
#pragma unroll
                    for (int bj = 0; bj < 2; ++bj) {
                        const u32x4 xr = xv[m][bj];
                        const f32x4 x0 = {bflo(xr.x), bfhi(xr.x), bflo(xr.y), bfhi(xr.y)}, x1 = {bflo(xr.z), bfhi(xr.z), bflo(xr.w), bfhi(xr.w)};
                        const f32x4 o0 = x0 + gv[bj][0] * acc[ai][bj][m][0], o1 = x1 + gv[bj][1] * acc[ai][bj][m][1];
                        u32x4 wv; wv.x = pk2(o0.x, o0.y); wv.y = pk2(o0.z, o0.w); wv.z = pk2(o1.x, o1.y); wv.w = pk2(o1.z, o1.w);
                        *(u32x4*)(dst + (size_t)(ai * 128 + m * 16) * D + bj * 128) = wv;
                    }
                asm volatile("" ::: "memory");
            }
        }
    }
};
struct EpiRelu2 {
    bf16_t* O;
    __device__ __forceinline__ void operator()(f32x4 (&acc)[2][2][4][2], int row0, int col0, int wc, int fq, int slice) const {
        const int colp = col0 + 4 * fq;
#pragma unroll
        for (int ai = 0; ai < 2; ++ai)
#pragma unroll
            for (int m = 0; m < 4; ++m) {
                const int row = row0 + ai * 128 + m * 16;
#pragma unroll
                for (int bj = 0; bj < 2; ++bj) {
                    f32x4 v0 = acc[ai][bj][m][0], v1 = acc[ai][bj][m][1];
                    v0.x = fmaxf(v0.x, 0.f); v0.y = fmaxf(v0.y, 0.f); v0.z = fmaxf(v0.z, 0.f); v0.w = fmaxf(v0.w, 0.f);
                    v1.x = fmaxf(v1.x, 0.f); v1.y = fmaxf(v1.y, 0.f); v1.z = fmaxf(v1.z, 0.f); v1.w = fmaxf(v1.w, 0.f);
                    v0 = v0 * v0; v1 = v1 * v1;
                    u32x4 wv; wv.x = pk2(v0.x, v0.y); wv.y = pk2(v0.z, v0.w); wv.z = pk2(v1.x, v1.y); wv.w = pk2(v1.z, v1.w);
                    *(u32x4*)(O + (size_t)row * DFF + colp + bj * 128) = wv;
                }
            }
    }
};

__device__ __forceinline__ int mrow(int j, int s, int dir, int b) {
    if (j < 4) { const int pos = j * 64 + s; return NLAT + b * CTXL + (dir ? (CTXL - 1 - pos) : pos); }
    const int pos = (j - 4) * 64 + s; return b * SEQ + (dir ? (SEQ - 1 - pos) : pos);
}
__device__ __forceinline__ int mtt(int j, int s, int dir) {
    if (j < 4) { const int pos = j * 64 + s; return SEQ + (dir ? (CTXL - 1 - pos) : pos); }
    const int pos = (j - 4) * 64 + s; return dir ? (SEQ - 1 - pos) : pos;
}
__device__ void mlstm_item(const Params& p, int l, int item, unsigned char* smem) {
    const int dir = item & 1, h = (item >> 1) & 7, b = item >> 4;
    bf16_t* Ks = (bf16_t*)smem;
    bf16_t* KwT = Ks + 64 * LDSS;
    bf16_t* VT0 = KwT + 64 * LDSS;
    bf16_t* Cs0 = VT0 + 2 * 48 * LDSS;
    float* gbA = (float*)(Cs0 + 2 * 48 * LDSS);
    float* gaA = gbA + 68 * 64;
    float* gpA = gaA + 68 * 64;
    const bf16_t* P = (const bf16_t*)(p.ws + WS_PA);
    const float* gates = (const float*)(p.ws + WS_GATES);
    bf16_t* hout = (bf16_t*)(p.ws + WS_HFB) + (size_t)dir * MTOT * 512;
    const int tid = otid(), lane = tid & 63, wid = tid >> 6, w = wid & 3, eh = wid >> 2, fr = lane & 15, fq = lane >> 4;
    bf16_t* VT = VT0 + eh * 48 * LDSS;
    bf16_t* Cs = Cs0 + eh * 48 * LDSS;
    const float big = p.b_gate[l * 32 + dir * 8 + h], bfg = p.b_gate[l * 32 + 16 + dir * 8 + h];
    for (int i = tid; i < 2 * 16 * LDSS; i += NTHR) { const int hh = i / (16 * LDSS), ii = i % (16 * LDSS); VT0[hh * 48 * LDSS + 32 * LDSS + ii] = (ii < LDSS) ? (bf16_t)0x3F80 : (bf16_t)0; }
    for (int i = tid; i < 2 * 48 * LDSS; i += NTHR) Cs0[i] = 0;
    f32x4 Cacc[3];
#pragma unroll
    for (int et = 0; et < 3; ++et) Cacc[et] = (f32x4){0.f, 0.f, 0.f, 0.f};
    float mst = 0.f;
    const int ls = tid >> 3, lpart = tid & 7;
    u32x4 rkA, rvA, rqA0, rqA1, rkB, rvB, rqB0, rqB1;
    {
        rkA = *(const u32x4*)(P + hm_off(1, b, h, mtt(0, ls, dir)) + lpart * 8);
        rvA = *(const u32x4*)(P + hm_off(2, b, h, mtt(0, ls, dir)) + lpart * 8);
        const bf16_t* pq = P + hm_off(0, b, h, mtt(0, w * 16 + fr, dir)) + fq * 8;
        rqA0 = *(const u32x4*)pq; rqA1 = *(const u32x4*)(pq + 32);
        rkB = *(const u32x4*)(P + hm_off(1, b, h, mtt(1, ls, dir)) + lpart * 8);
        rvB = *(const u32x4*)(P + hm_off(2, b, h, mtt(1, ls, dir)) + lpart * 8);
        const bf16_t* pq1 = P + hm_off(0, b, h, mtt(1, w * 16 + fr, dir)) + fq * 8;
        rqB0 = *(const u32x4*)pq1; rqB1 = *(const u32x4*)(pq1 + 32);
    }
    {
        float gi[9], gf[9];
#pragma unroll
        for (int i = 0; i < 9; ++i) {
            const int jj = wid + 8 * i;
            gi[i] = 0.f; gf[i] = 0.f;
            if (jj < 68) { const size_t rg = (size_t)mrow(jj, lane, dir, b) * 32; gi[i] = gates[rg + dir * 8 + h]; gf[i] = gates[rg + 16 + dir * 8 + h]; }
        }
#pragma unroll
        for (int i = 0; i < 9; ++i) {
            const int jj = wid + 8 * i;
            if (jj < 68) {
                const float fg = gf[i] + bfg;
                float v = fminf(fg, 0.f) - log1pf(__expf(-fabsf(fg)));
#pragma unroll
                for (int o = 1; o < 64; o <<= 1) { const float t = __shfl_up(v, o); if (lane >= o) v += t; }
                float a = (gi[i] + big) - v, pm = a;
#pragma unroll
                for (int o = 1; o < 64; o <<= 1) { const float t = __shfl_up(pm, o); if (lane >= o) pm = fmaxf(pm, t); }
                gbA[jj * 64 + lane] = v; gaA[jj * 64 + lane] = a; gpA[jj * 64 + lane] = pm;
            }
        }
    }
    __syncthreads();
    auto step = [&](const int j, u32x4& rk0, u32x4& rv, u32x4& rq0, u32x4& rq1) __attribute__((always_inline)) {
        const bf16x8 qf0 = as_bf16x8(rq0), qf1 = as_bf16x8(rq1);
        const u32x4 k0 = rk0;
        *(u32x4*)(Ks + ls * LDSS + lpart * 8) = k0;
        {
            bf16_t* vd = VT0 + (lpart >> 2) * 48 * LDSS + ((lpart & 3) * 8) * LDSS + ((ls + 8 * (lpart & 3) + 32 * (lpart >> 2)) & 63);
            vd[0 * LDSS] = (bf16_t)(rv.x & 0xffff); vd[1 * LDSS] = (bf16_t)(rv.x >> 16);
            vd[2 * LDSS] = (bf16_t)(rv.y & 0xffff); vd[3 * LDSS] = (bf16_t)(rv.y >> 16);
            vd[4 * LDSS] = (bf16_t)(rv.z & 0xffff); vd[5 * LDSS] = (bf16_t)(rv.z >> 16);
            vd[6 * LDSS] = (bf16_t)(rv.w & 0xffff); vd[7 * LDSS] = (bf16_t)(rv.w >> 16);
        }
        const float* gb = gbA + j * 64; const float* ga = gaA + j * 64; const float* gp = gpA + j * 64;
        const float pm63 = gp[63], bend = gb[63];
        {
            const float wk = __expf(ga[ls] - pm63);
            bf16_t* kd = KwT + (lpart * 8) * LDSS + ((ls + 8 * lpart) & 63);
            kd[0 * LDSS] = f2bf(bflo(k0.x) * wk); kd[1 * LDSS] = f2bf(bfhi(k0.x) * wk);
            kd[2 * LDSS] = f2bf(bflo(k0.y) * wk); kd[3 * LDSS] = f2bf(bfhi(k0.y) * wk);
            kd[4 * LDSS] = f2bf(bflo(k0.z) * wk); kd[5 * LDSS] = f2bf(bfhi(k0.z) * wk);
            kd[6 * LDSS] = f2bf(bflo(k0.w) * wk); kd[7 * LDSS] = f2bf(bfhi(k0.w) * wk);
        }
        if (j + 2 < 68) {
            rk0 = *(const u32x4*)(P + hm_off(1, b, h, mtt(j + 2, ls, dir)) + lpart * 8);
            rv = *(const u32x4*)(P + hm_off(2, b, h, mtt(j + 2, ls, dir)) + lpart * 8);
            const bf16_t* pq = P + hm_off(0, b, h, mtt(j + 2, w * 16 + fr, dir)) + fq * 8;
            rq0 = *(const u32x4*)pq; rq1 = *(const u32x4*)(pq + 32);
        }
        __syncthreads();
        const int t = w * 16 + fr;
        const float pt = gp[t], bt = gb[t];
        bf16x8 pf[2];
        {
            f32x4 sv[4];
#pragma unroll
            for (int st = 0; st < 4; ++st) {
                f32x4 a4 = {0.f, 0.f, 0.f, 0.f};
                a4 = mfma16(*(const bf16x8*)(Ks + (st * 16 + fr) * LDSS + fq * 8), qf0, a4);
                a4 = mfma16(*(const bf16x8*)(Ks + (st * 16 + fr) * LDSS + 32 + fq * 8), qf1, a4);
                const f32x4 av = *(const f32x4*)(ga + st * 16 + fq * 4);
                const int s0 = st * 16 + fq * 4;
                sv[st].x = (s0 + 0 <= t) ? a4.x * __expf(av.x - pt) : 0.f;
                sv[st].y = (s0 + 1 <= t) ? a4.y * __expf(av.y - pt) : 0.f;
                sv[st].z = (s0 + 2 <= t) ? a4.z * __expf(av.z - pt) : 0.f;
                sv[st].w = (s0 + 3 <= t) ? a4.w * __expf(av.w - pt) : 0.f;
            }
#pragma unroll
            for (int k2 = 0; k2 < 2; ++k2) {
                u32x4 u; u.x = pk2(sv[2 * k2].x, sv[2 * k2].y); u.y = pk2(sv[2 * k2].z, sv[2 * k2].w); u.z = pk2(sv[2 * k2 + 1].x, sv[2 * k2 + 1].y); u.w = pk2(sv[2 * k2 + 1].z, sv[2 * k2 + 1].w);
                pf[k2] = as_bf16x8(u);
            }
        }
        const float mx = fmaxf(mst, pt), wprev = __expf(mst - mx), rr = __expf(pt - mx);
        f32x4 num[3];
#pragma unroll
        for (int et = 0; et < 3; ++et) {
            f32x4 apv = {0.f, 0.f, 0.f, 0.f}, aqc = {0.f, 0.f, 0.f, 0.f};
#pragma unroll
            for (int k2 = 0; k2 < 2; ++k2) {
                u32x4 u;
                const int skv = 8 * (et * 2 + (fr >> 3)) + 32 * eh;
                const u32x2 lo = *(const u32x2*)(VT + (et * 16 + fr) * LDSS + ((32 * k2 + fq * 4 + skv) & 63)), hi = *(const u32x2*)(VT + (et * 16 + fr) * LDSS + ((32 * k2 + 16 + fq * 4 + skv) & 63));
                u.x = lo.x; u.y = lo.y; u.z = hi.x; u.w = hi.y;
                apv = mfma16(as_bf16x8(u), pf[k2], apv);
            }
            aqc = mfma16(*(const bf16x8*)(Cs + (et * 16 + fr) * LDSS + fq * 8), qf0, aqc);
            aqc = mfma16(*(const bf16x8*)(Cs + (et * 16 + fr) * LDSS + 32 + fq * 8), qf1, aqc);
            num[et] = aqc * wprev + apv * rr;
        }
        {
            const float qn = __shfl(num[2].x, fr);
            const float den = fmaxf(fabsf(qn), __expf(-(bt + mx)));
            const float inv = 1.0f / den;
            bf16_t* ho = hout + (size_t)mrow(j, t, dir, b) * 512 + h * 64 + eh * 32 + fq * 4;
#pragma unroll
            for (int et = 0; et < 2; ++et) {
                const f32x4 hv = num[et] * inv;
                u32x2 wv; wv.x = pk2(hv.x, hv.y); wv.y = pk2(hv.z, hv.w);
                *(u32x2*)(ho + et * 16) = wv;
            }
        }
        f32x4 dC[3];
#pragma unroll
        for (int et = 0; et < 3; ++et) {
            dC[et] = (f32x4){0.f, 0.f, 0.f, 0.f};
#pragma unroll
            for (int ks = 0; ks < 2; ++ks)
                dC[et] = mfma16(*(const bf16x8*)(KwT + (w * 16 + fr) * LDSS + ((ks * 32 + fq * 8 + 8 * (w * 2 + (fr >> 3))) & 63)), *(const bf16x8*)(VT + (et * 16 + fr) * LDSS + ((ks * 32 + fq * 8 + 8 * (et * 2 + (fr >> 3)) + 32 * eh) & 63)), dC[et]);
        }
        __syncthreads();
        {
            const float mx63 = fmaxf(mst, pm63), wc = __expf(mst - mx63), sc2 = __expf(pm63 - mx63);
#pragma unroll
            for (int et = 0; et < 3; ++et) {
                Cacc[et] = Cacc[et] * wc + dC[et] * sc2;
                u32x2 wv; wv.x = pk2(Cacc[et].x, Cacc[et].y); wv.y = pk2(Cacc[et].z, Cacc[et].w);
                *(u32x2*)(Cs + (et * 16 + fr) * LDSS + w * 16 + fq * 4) = wv;
            }
            mst = bend + mx63;
        }
    };
#pragma unroll 1
    for (int j = 0; j < 68; j += 2) { step(j, rkA, rvA, rqA0, rqA1); step(j + 1, rkB, rvB, rqB0, rqB1); }
}

template <int QABS0, bool LOCAL>
__device__ __forceinline__ void na_chunk(const bf16_t* Ks, const bf16_t* VT, const float* rb, unsigned vmask, const bf16x8 (&qf)[2][2], f32x4 (&O)[4][2], float (&mrun)[2], float (&lrun)[2], int fr, int fq) {
    bf16x8 Kf[4][2];
#pragma unroll
    for (int kt = 0; kt < 4; ++kt)
#pragma unroll
        for (int ks = 0; ks < 2; ++ks) Kf[kt][ks] = *(const bf16x8*)(Ks + (kt * 16 + fr) * LDSS + ks * 32 + fq * 8);
    bf16x8 pf[2][2];
    float alph[2];
#pragma unroll
    for (int qt = 0; qt < 2; ++qt) {
        constexpr int dummy = 0; (void)dummy;
        const int qabs = QABS0 + qt;
        const int klo = LOCAL ? (qabs > 0 ? qabs - 1 : 0) : 0, khi = LOCAL ? (qabs < 3 ? qabs + 1 : 3) : 3;
        const float* rbq = rb - 16 * qabs;
        f32x4 sv[4];
        float mx = -1e30f;
#pragma unroll
        for (int kt = 0; kt < 4; ++kt) {
            if (kt >= klo && kt <= khi) {
                sv[kt] = mfma16(Kf[kt][0], qf[qt][0], (f32x4){0.f, 0.f, 0.f, 0.f});
                sv[kt] = mfma16(Kf[kt][1], qf[qt][1], sv[kt]);
                if (LOCAL) {
                    float bz0 = rbq[16 * kt + 0], bz1 = rbq[16 * kt + 1], bz2 = rbq[16 * kt + 2], bz3 = rbq[16 * kt + 3];
                    asm volatile("" : "+v"(bz0), "+v"(bz1), "+v"(bz2), "+v"(bz3));
                    sv[kt].x = ((vmask >> (qt * 16 + kt * 4 + 0)) & 1u) ? (sv[kt].x + bz0) : -1e30f;
                    sv[kt].y = ((vmask >> (qt * 16 + kt * 4 + 1)) & 1u) ? (sv[kt].y + bz1) : -1e30f;
                    sv[kt].z = ((vmask >> (qt * 16 + kt * 4 + 2)) & 1u) ? (sv[kt].z + bz2) : -1e30f;
                    sv[kt].w = ((vmask >> (qt * 16 + kt * 4 + 3)) & 1u) ? (sv[kt].w + bz3) : -1e30f;
                }
                mx = fmaxf(mx, fmaxf(fmaxf(sv[kt].x, sv[kt].y), fmaxf(sv[kt].z, sv[kt].w)));
            } else sv[kt] = (f32x4){0.f, 0.f, 0.f, 0.f};
        }
        mx = fmaxf(mx, __shfl_xor(mx, 16)); mx = fmaxf(mx, __shfl_xor(mx, 32));
        const float mnew = fmaxf(mrun[qt], mx);
        alph[qt] = __expf(mrun[qt] - mnew);
        mrun[qt] = mnew;
        float ls = 0.f;
#pragma unroll
        for (int kt = 0; kt < 4; ++kt) {
            if (kt >= klo && kt <= khi) {
                sv[kt].x = __expf(sv[kt].x - mnew); sv[kt].y = __expf(sv[kt].y - mnew); sv[kt].z = __expf(sv[kt].z - mnew); sv[kt].w = __expf(sv[kt].w - mnew);
                ls += (sv[kt].x + sv[kt].y) + (sv[kt].z + sv[kt].w);
            }
        }
        lrun[qt] = lrun[qt] * alph[qt] + ls;
#pragma unroll
        for (int k2 = 0; k2 < 2; ++k2) {
            u32x4 u; u.x = pk2(sv[2 * k2].x, sv[2 * k2].y); u.y = pk2(sv[2 * k2].z, sv[2 * k2].w); u.z = pk2(sv[2 * k2 + 1].x, sv[2 * k2 + 1].y); u.w = pk2(sv[2 * k2 + 1].z, sv[2 * k2 + 1].w);
            pf[qt][k2] = as_bf16x8(u);
        }
    }
#pragma unroll
    for (int dt = 0; dt < 4; ++dt) {
        bf16x8 Vf[2];
#pragma unroll
        for (int k2 = 0; k2 < 2; ++k2) {
            const int sk = 8 * (dt * 2 + (fr >> 3));
            const u32x2 lo2 = *(const u32x2*)(VT + (dt * 16 + fr) * LDSS + ((32 * k2 + fq * 4 + sk) & 63)), hi2 = *(const u32x2*)(VT + (dt * 16 + fr) * LDSS + ((32 * k2 + 16 + fq * 4 + sk) & 63));
            u32x4 u; u.x = lo2.x; u.y = lo2.y; u.z = hi2.x; u.w = hi2.y;
            Vf[k2] = as_bf16x8(u);
        }
#pragma unroll
        for (int qt = 0; qt < 2; ++qt) {
            const int qabs = QABS0 + qt;
            const int klo = LOCAL ? (qabs > 0 ? qabs - 1 : 0) : 0, khi = LOCAL ? (qabs < 3 ? qabs + 1 : 3) : 3;
            O[dt][qt] = O[dt][qt] * alph[qt];
            if (klo <= 1) O[dt][qt] = mfma16(Vf[0], pf[qt][0], O[dt][qt]);
            if (khi >= 2) O[dt][qt] = mfma16(Vf[1], pf[qt][1], O[dt][qt]);
        }
    }
}

__device__ void na_item(const Params& p, int l, int item, bool isctx, unsigned char* smem) {
    bf16_t* Ks = (bf16_t*)smem;
    bf16_t* VT = Ks + 64 * LDSS;
    float* rp = (float*)(VT + 64 * LDSS);
    const bf16_t* P = (const bf16_t*)(p.ws + WS_PA);
    bf16_t* Y = (bf16_t*)(p.ws + WS_HB);
    const int tid = otid(), lane = tid & 63, w = tid >> 6, fr = lane & 15, fq = lane >> 4;
    int b, h, rg;
    if (isctx) { rg = 0; h = item & 7; b = item >> 3; } else { rg = item & 15; h = (item >> 4) & 7; b = item >> 7; }
    const int r = rg * 4 + (w >> 1);
    const int qc0 = (w & 1) * 32;
    const int rs = min(max(r - 4, 0), 56);
    const int qrow0 = isctx ? (NLAT + b * CTXL + w * 32) : (b * SEQ + r * 64 + qc0);
    const int qtt0 = isctx ? (SEQ + w * 32) : (r * 64 + qc0);
    bf16x8 qf[2][2];
#pragma unroll
    for (int qt = 0; qt < 2; ++qt)
#pragma unroll
        for (int ks = 0; ks < 2; ++ks) qf[qt][ks] = *(const bf16x8*)(P + hm_off(3, b, h, qtt0 + qt * 16 + fr) + ks * 32 + fq * 8);
    for (int i = tid; i < 15 * 64; i += NTHR) { const int x = (i & 63) - 16; rp[i] = (x >= 0 && x < 31) ? p.rpb[(size_t)(l * 8 + h) * 15 * 31 + (i >> 6) * 31 + x] : 0.f; }
    unsigned vmask = 0u;
#pragma unroll
    for (int qt = 0; qt < 2; ++qt) {
        const int qc = qc0 + qt * 16 + fr, cs = min(max(qc - 8, 0), 48);
#pragma unroll
        for (int kt = 0; kt < 4; ++kt)
#pragma unroll
            for (int jj = 0; jj < 4; ++jj) { const int kc = kt * 16 + fq * 4 + jj; if (kc >= cs && kc < cs + 16) vmask |= 1u << (qt * 16 + kt * 4 + jj); }
    }
    f32x4 O[4][2];
    float mrun[2], lrun[2];
#pragma unroll
    for (int qt = 0; qt < 2; ++qt) {
        mrun[qt] = -1e30f; lrun[qt] = 0.f;
#pragma unroll
        for (int dt = 0; dt < 4; ++dt) O[dt][qt] = (f32x4){0.f, 0.f, 0.f, 0.f};
    }
    const int lo = isctx ? 0 : min(max(rg * 4 - 4, 0), 56);
    const int hi = isctx ? -1 : (min(max(rg * 4 + 3 - 4, 0), 56) + 7);
    const int nloc = hi - lo + 1, nch = nloc + 4;
    const int lkey = tid >> 3, lpart = tid & 7;
    u32x4 rk0, rv0;
    {
        const int ktt0 = (0 < nloc) ? (lo * 64) : SEQ;
        rk0 = *(const u32x4*)(P + hm_off(4, b, h, ktt0 + lkey) + lpart * 8);
        rv0 = *(const u32x4*)(P + hm_off(5, b, h, ktt0 + lkey) + lpart * 8);
    }
#pragma unroll 1
    for (int c = 0; c < nch; ++c) {
        *(u32x4*)(Ks + lkey * LDSS + lpart * 8) = rk0;
        {
            bf16_t* vd = VT + (lpart * 8) * LDSS + ((lkey + 8 * lpart) & 63);
            vd[0 * LDSS] = (bf16_t)(rv0.x & 0xffff); vd[1 * LDSS] = (bf16_t)(rv0.x >> 16);
            vd[2 * LDSS] = (bf16_t)(rv0.y & 0xffff); vd[3 * LDSS] = (bf16_t)(rv0.y >> 16);
            vd[4 * LDSS] = (bf16_t)(rv0.z & 0xffff); vd[5 * LDSS] = (bf16_t)(rv0.z >> 16);
            vd[6 * LDSS] = (bf16_t)(rv0.w & 0xffff); vd[7 * LDSS] = (bf16_t)(rv0.w >> 16);
        }
        if (c + 1 < nch) {
            const int cn = c + 1;
            const int ktt0 = (cn < nloc) ? ((lo + cn) * 64) : (SEQ + (cn - nloc) * 64);
            rk0 = *(const u32x4*)(P + hm_off(4, b, h, ktt0 + lkey) + lpart * 8);
            rv0 = *(const u32x4*)(P + hm_off(5, b, h, ktt0 + lkey) + lpart * 8);
        }
        __syncthreads();
        const bool local = c < nloc;
        const int kr = lo + c;
        const bool active = !local || (kr >= rs && kr < rs + 8);
        if (active) {
            const float* rb = rp + (kr - r + 7) * 64 + 31 + fq * 4 - fr;
            if (!local) na_chunk<0, false>(Ks, VT, rb, vmask, qf, O, mrun, lrun, fr, fq);
            else if (w & 1) na_chunk<2, true>(Ks, VT, rb, vmask, qf, O, mrun, lrun, fr, fq);
            else na_chunk<0, true>(Ks, VT, rb, vmask, qf, O, mrun, lrun, fr, fq);
        }
        __syncthreads();
    }
#pragma unroll
    for (int qt = 0; qt < 2; ++qt) {
        float lt = lrun[qt];
        lt += __shfl_xor(lt, 16); lt += __shfl_xor(lt, 32);
        const float inv = 1.0f / lt;
        bf16_t* yo = Y + (size_t)(qrow0 + qt * 16 + fr) * D + 512 + h * 64 + fq * 4;
#pragma unroll
        for (int dt = 0; dt < 4; ++dt) {
            const f32x4 ov = O[dt][qt] * inv;
            u32x2 wv; wv.x = pk2(ov.x, ov.y); wv.y = pk2(ov.z, ov.w);
            *(u32x2*)(yo + dt * 16) = wv;
        }
    }
}

__device__ void phase_mixers(const Params& p, int l, unsigned char* smem) {
    __shared__ int s_item;
    unsigned* ctr = (unsigned*)(p.ws + WS_CTL) + l;
    const int nitems = 128 + 1024 + ((l < DEPTH - 1) ? 64 : 0);
    for (;;) {
        __syncthreads();
        if (threadIdx.x == 0) s_item = (int)atomicAdd(ctr, 1u);
        __syncthreads();
        const int item = s_item;
        if (item >= nitems) break;
        if (item < 128) { mlstm_item(p, l, item, smem); continue; }
        if (item < 1152) na_item(p, l, item - 128, false, smem);
        else na_item(p, l, item - 1152, true, smem);
    }
}

__device__ void phase_mfinal(const Params& p, int l) {
    const int nrows = (l < DEPTH - 1) ? MTOT : NLAT;
    const bf16_t* P = (const bf16_t*)(p.ws + WS_PA);
    const bf16_t* HF = (const bf16_t*)(p.ws + WS_HFB);
    const bf16_t* HBk = HF + (size_t)MTOT * 512;
    bf16_t* Y = (bf16_t*)(p.ws + WS_HB);
    const float* g = p.mlstm_norm_g + l * 512;
    const int tid = otid(), lane = tid & 63, nw = gridDim.x * NWAVE, c = lane * 8;
    const f32x4 g0 = *(const f32x4*)(g + c), g1 = *(const f32x4*)(g + c + 4);
    const float gg[8] = {g0.x, g0.y, g0.z, g0.w, g1.x, g1.y, g1.z, g1.w};
    for (int row0 = blockIdx.x * NWAVE + (tid >> 6); row0 < nrows; row0 += 4 * nw) {
        u32x4 a[4], bq[4], o[4];
#pragma unroll
        for (int i = 0; i < 4; ++i) {
            const int r = min(row0 + i * nw, nrows - 1);
            a[i] = *(const u32x4*)(HF + (size_t)r * 512 + c); bq[i] = *(const u32x4*)(HBk + (size_t)r * 512 + c); o[i] = *(const u32x4*)(P + OG_OFF + (size_t)r * 512 + c);
        }
#pragma unroll
        for (int i = 0; i < 4; ++i) {
            const int row = row0 + i * nw;
            if (row >= nrows) continue;
            float v[8];
            v[0] = bflo(a[i].x) + bflo(bq[i].x); v[1] = bfhi(a[i].x) + bfhi(bq[i].x); v[2] = bflo(a[i].y) + bflo(bq[i].y); v[3] = bfhi(a[i].y) + bfhi(bq[i].y);
            v[4] = bflo(a[i].z) + bflo(bq[i].z); v[5] = bfhi(a[i].z) + bfhi(bq[i].z); v[6] = bflo(a[i].w) + bflo(bq[i].w); v[7] = bfhi(a[i].w) + bfhi(bq[i].w);
            float s = ((v[0] + v[1]) + (v[2] + v[3])) + ((v[4] + v[5]) + (v[6] + v[7]));
            s += __shfl_xor(s, 1); s += __shfl_xor(s, 2); s += __shfl_xor(s, 4);
            const float mu = s * (1.f / 64.f);
            float q = 0.f;
#pragma unroll
            for (int k = 0; k < 8; ++k) { v[k] -= mu; q += v[k] * v[k]; }
            q += __shfl_xor(q, 1); q += __shfl_xor(q, 2); q += __shfl_xor(q, 4);
            const float rstd = 1.0f / sqrtf(q * (1.f / 64.f) + 1e-6f);
            float ov[8];
            ov[0] = bflo(o[i].x); ov[1] = bfhi(o[i].x); ov[2] = bflo(o[i].y); ov[3] = bfhi(o[i].y); ov[4] = bflo(o[i].z); ov[5] = bfhi(o[i].z); ov[6] = bflo(o[i].w); ov[7] = bfhi(o[i].w);
            float y[8];
#pragma unroll
            for (int k = 0; k < 8; ++k) y[k] = v[k] * rstd * gg[k] / (1.f + __expf(-ov[k]));
            u32x4 wv; wv.x = pk2(y[0], y[1]); wv.y = pk2(y[2], y[3]); wv.z = pk2(y[4], y[5]); wv.w = pk2(y[6], y[7]);
            *(u32x4*)(Y + (size_t)row * D + c) = wv;
        }
    }
}

__device__ void phase_final(const Params& p) {
    const bf16_t* xb = (const bf16_t*)(p.ws + WS_XB);
    const int tid = otid(), lane = tid & 63, nw = gridDim.x * NWAVE;
    for (int row0 = blockIdx.x * NWAVE + (tid >> 6); row0 < NLAT; row0 += 4 * nw) {
        u32x2 q[4][4];
#pragma unroll
        for (int i = 0; i < 4; ++i) {
            const int r = min(row0 + i * nw, NLAT - 1);
#pragma unroll
            for (int j = 0; j < 4; ++j) q[i][j] = ((const u32x2*)(xb + (size_t)r * D))[lane + 64 * j];
        }
#pragma unroll
        for (int i = 0; i < 4; ++i) {
            const int row = row0 + i * nw;
            if (row >= NLAT) continue;
            f32x4 v[4];
            float s = 0.f;
#pragma unroll
            for (int j = 0; j < 4; ++j) { v[j] = (f32x4){bflo(q[i][j].x), bfhi(q[i][j].x), bflo(q[i][j].y), bfhi(q[i][j].y)}; s += (v[j].x * v[j].x + v[j].y * v[j].y) + (v[j].z * v[j].z + v[j].w * v[j].w); }
            s = wave_sum(s);
            const float rstd = 1.0f / sqrtf(s * (1.f / D) + 1e-6f);
#pragma unroll
            for (int j = 0; j < 4; ++j) {
                const f32x4 gv = *(const f32x4*)(p.final_g + (lane + 64 * j) * 4);
                ((f32x4*)(p.out + (size_t)row * D))[lane + 64 * j] = v[j] * rstd * gv;
            }
        }
    }
}

#define XB_TMO      128
#define XB_XCNT(j)  (256  + 64 * (j))
#define XB_XSUB(j)  (1280 + 64 * (j))
#define XB_XGEN(j)  (2304 + 64 * (j))
#define XB_TOP      3328
#define XB_TOPGEN   3392
#define XCD_BAR_WORDS 3456
#define XB_SPIN_CAP (1u << 18)
__device__ __forceinline__ unsigned xb_ld(unsigned* p)              { return __hip_atomic_load(p, __ATOMIC_RELAXED, __HIP_MEMORY_SCOPE_AGENT); }
__device__ __forceinline__ unsigned xb_add(unsigned* p, unsigned v) { return __hip_atomic_fetch_add(p, v, __ATOMIC_RELAXED, __HIP_MEMORY_SCOPE_AGENT); }
__device__ __forceinline__ unsigned xb_xcc_id() { return (unsigned)__builtin_amdgcn_s_getreg((3 << 11) | 20) & 0xFu; }
#define XB_SPIN(cond, bar) do { unsigned _sp = 0; while (cond) { __builtin_amdgcn_s_sleep(1); \
    if ((++_sp & 255u) == 0u) { if (xb_ld(&(bar)[XB_TMO])) break; if (_sp > XB_SPIN_CAP) { atomicAdd(&(bar)[XB_TMO], 1u); break; } } } } while (0)
struct XcdBarrier { unsigned* bar; unsigned x; volatile LAS unsigned* st; };
__device__ __forceinline__ XcdBarrier xcd_barrier_post(unsigned* bar, volatile LAS unsigned* st) {
    XcdBarrier b; b.bar = bar; b.x = xb_xcc_id(); b.st = st;
    if (threadIdx.x == 0) (void)xb_add(&bar[XB_XCNT(b.x)], 1u);
    return b;
}
__device__ __forceinline__ void xcd_barrier_complete(unsigned* bar, unsigned x, unsigned& nloc, unsigned& nx) {
    const unsigned G = gridDim.x * gridDim.y * gridDim.z;
    unsigned sum, cnt, mine, sp = 0u;
    for (;;) {
        sum = 0u; cnt = 0u; mine = 0u;
#pragma unroll
        for (unsigned j = 0; j < 16; ++j) { const unsigned c = xb_ld(&bar[XB_XCNT(j)]); sum += c; cnt += (c > 0u) ? 1u : 0u; mine = (j == x) ? c : mine; }
        if (sum == G) break;
        __builtin_amdgcn_s_sleep(1);
        if ((++sp & 255u) == 0u) { if (xb_ld(&bar[XB_TMO])) break; if (sp > XB_SPIN_CAP) { atomicAdd(&bar[XB_TMO], 1u); break; } }
    }
    nloc = mine > 0u ? mine : 1u; nx = cnt > 0u ? cnt : 1u;
}
__device__ __forceinline__ void xcd_barrier(const XcdBarrier& b) {
    asm volatile("s_waitcnt vmcnt(0)" ::: "memory");
    __syncthreads();
    if (threadIdx.x == 0) {
        unsigned* bar = b.bar;
        __builtin_amdgcn_s_waitcnt(0);
        unsigned nloc = b.st[0], nx = b.st[1];
        if (nloc == 0u) { xcd_barrier_complete(bar, b.x, nloc, nx); b.st[0] = nloc; b.st[1] = nx; }
        const unsigned old = xb_add(&bar[XB_XSUB(b.x)], 1u);
        const unsigned gen = old / nloc;
        if (old + 1u == (gen + 1u) * nloc) {
            __builtin_amdgcn_fence(__ATOMIC_RELEASE, "agent");
            asm volatile("s_waitcnt vmcnt(0)" ::: "memory");
            const unsigned og = xb_add(&bar[XB_TOP], 1u);
            const unsigned tg = og / nx;
            if (og + 1u == (tg + 1u) * nx) xb_add(&bar[XB_TOPGEN], 1u);
            else XB_SPIN(xb_ld(&bar[XB_TOPGEN]) == tg, bar);
            __builtin_amdgcn_fence(__ATOMIC_ACQUIRE, "agent");
            xb_add(&bar[XB_XGEN(b.x)], 1u);
            asm volatile("s_waitcnt vmcnt(0)" ::: "memory");
        } else {
            XB_SPIN(xb_ld(&bar[XB_XGEN(b.x)]) == gen, bar);
            __builtin_amdgcn_fence(__ATOMIC_ACQUIRE, "agent");
            asm volatile("s_waitcnt vmcnt(0)" ::: "memory");
        }
    }
    __syncthreads();
}

__global__ void __launch_bounds__(512) fwd_kernel(Params p) {
    extern __shared__ __attribute__((aligned(16))) unsigned char smem[];
    cg::grid_group grid = cg::this_grid();
    __shared__ __attribute__((aligned(16))) unsigned xb_words[4];
    if (threadIdx.x < 4) xb_words[threadIdx.x] = 0u;
    __syncthreads();
    const XcdBarrier xb = xcd_barrier_post((unsigned*)(p.ws + WS_CTL) + 256, (volatile LAS unsigned*)xb_words);
    int ph = 0;
#define PHASE(...) { if (ph >= p.ph_lo && ph < p.ph_hi) { __VA_ARGS__; if (ph + 1 < p.ph_hi) { if (p.ph_lo < 0) grid.sync(); else xcd_barrier(xb); } } ++ph; }
    PHASE(phase_prologue(p, smem));
    float* xc = (float*)(p.ws + WS_XC);
    bf16_t* HB = (bf16_t*)(p.ws + WS_HB);
    bf16_t* PA = (bf16_t*)(p.ws + WS_PA);
#pragma unroll 1
    for (int l = 0; l < DEPTH; ++l) {
        const float* modl = (const float*)(p.ws + WS_MODS) + (size_t)l * 9 * NMODC;
        const float* xlat32 = (l == 0) ? p.x : nullptr;
        bf16_t* xres = (bf16_t*)(p.ws + WS_XB);
        float* xctx = xc;
        const int mrows = (l < DEPTH - 1) ? MTOT : NLAT;
        PHASE({ norm_rows(xlat32, xres, xctx, MTOT, p.norm1_g + l * D, modl, 0, D, HB, (const float*)(p.ws + WS_HFB), (l > 0) ? 8 : 0); convert_weights(p, l, smem); });
        PHASE({ EpiInProj e{PA, (float*)(p.ws + WS_GATES), (const float*)(p.ws + WS_ROPE), (const float*)(p.ws + WS_ROPE) + SEQ * 32};
                gemm_phase(HB, (const bf16_t*)(p.ws + WS_WIN), MTOT, DINP, D, e, smem); });
        PHASE(phase_mixers(p, l, smem));
        PHASE(phase_mfinal(p, l));
        PHASE({ EpiResid e{xlat32, xres, xres, modl + 2 * D, (float*)(p.ws + WS_HFB)};
                gemm_phase(HB, (const bf16_t*)(p.ws + WS_WOUT), mrows, D, D, e, smem, (mrows > NLAT) ? 4 : 1); });
        PHASE(norm_rows(nullptr, xres, xc, mrows, p.norm2_g + l * D, modl, 3 * D, 4 * D, HB, (const float*)(p.ws + WS_HFB), 4));
        PHASE({ EpiRelu2 e{PA};
                gemm_phase(HB, (const bf16_t*)(p.ws + WS_W1), mrows, DFF, D, e, smem); });
        PHASE({ EpiResid e{nullptr, xres, xres, modl + 5 * D, (float*)(p.ws + WS_HFB)};
                gemm_phase(PA, (const bf16_t*)(p.ws + WS_W2), mrows, D, DFF, e, smem, (mrows > NLAT) ? 8 : 1); });
    }
    PHASE(phase_final(p));
#undef PHASE
}

constexpr int N_PHASES = 2 + 8 * DEPTH;

extern "C" void kernel_launch(void* const* d_in, const int* in_sizes, int n_in, void* d_out, int out_size, void* d_ws, size_t ws_size, hipStream_t stream) {
    static int grid_blocks = 0;
    if (grid_blocks == 0) {
        if (n_in != 16 || out_size != NLAT * D || ws_size < WS_END) { fprintf(stderr, "kernel_launch: unexpected shapes (n_in %d out %d ws %zu need %zu)\n", n_in, out_size, ws_size, (size_t)WS_END); grid_blocks = -1; return; }
        int dev = 0, cus = 0, per_cu = 0;
        (void)hipGetDevice(&dev);
        (void)hipDeviceGetAttribute(&cus, hipDeviceAttributeMultiprocessorCount, dev);
        (void)hipFuncSetAttribute((const void*)fwd_kernel, hipFuncAttributeMaxDynamicSharedMemorySize, SHM_BYTES);
        (void)hipOccupancyMaxActiveBlocksPerMultiprocessor(&per_cu, (const void*)fwd_kernel, NTHR, SHM_BYTES);
        if (per_cu < 1) per_cu = 1;
        if (per_cu > 1) per_cu = 1;
        grid_blocks = cus * per_cu;
    }
    if (grid_blocks < 0) return;
    (void)hipMemsetAsync((char*)d_ws + WS_CTL, 0, 16384, stream);
    Params p{};
    p.x = (const float*)d_in[0]; p.c = (const float*)d_in[1]; p.ctx = (const float*)d_in[2]; p.c_ctx = (const float*)d_in[3];
    p.w_ada = (const float*)d_in[4]; p.b_ada = (const float*)d_in[5]; p.norm1_g = (const float*)d_in[6]; p.w_in = (const float*)d_in[7];
    p.b_gate = (const float*)d_in[8]; p.mlstm_norm_g = (const float*)d_in[9]; p.rpb = (const float*)d_in[10]; p.w_out = (const float*)d_in[11];
    p.norm2_g = (const float*)d_in[12]; p.w_mlp1 = (const float*)d_in[13]; p.w_mlp2 = (const float*)d_in[14]; p.final_g = (const float*)d_in[15];
    p.out = (float*)d_out; p.ws = (unsigned char*)d_ws;
#if defined(MULTI_LAUNCH)
    for (int ph = 0; ph < N_PHASES; ++ph) {
        p.ph_lo = ph; p.ph_hi = ph + 1;
        hipLaunchKernelGGL(fwd_kernel, dim3(grid_blocks), dim3(NTHR), SHM_BYTES, stream, p);
    }
#else
    p.ph_lo = 0; p.ph_hi = N_PHASES;
    void* args[] = {&p};
    hipError_t e = hipLaunchCooperativeKernel((const void*)fwd_kernel, dim3(grid_blocks), dim3(NTHR), args, SHM_BYTES, stream);
    if (e != hipSuccess) fprintf(stderr, "cooperative launch failed: %s (grid %d)\n", hipGetErrorString(e), grid_blocks);
#endif
}
```
